# Optimizing an MI355X kernel written in HIP

```python
import math, functools
import jax, jax.numpy as jnp
from jax import lax
import numpy as np

D_MODEL = 2048
BATCH = 2
SEQ = 8192
DEPTH = 1
DEC_BATCH = 16
DEC_SEQ = 16
PAST_LEN = 1024

CHUNK = 64
D_FF = 4096
D_CONV = 1024
CONV_W = 3
N_HEADS = 16
N_KV = 4
HEAD_DIM = 64
GROUP = N_HEADS // N_KV
WINDOW = 128
WIN_ROWS = WINDOW
N_BAND = WINDOW // CHUNK + 1
N_BUCKETS = 32
MAX_DIST = 128
D_PLE = 256
EPS = 1e-6
NEG = -1e30

COL_SIZES = (D_CONV, D_CONV, D_CONV, N_HEADS * HEAD_DIM, N_KV * HEAD_DIM, N_KV * HEAD_DIM, D_MODEL, D_MODEL)
W_IN_COLS = sum(COL_SIZES)
SPLIT_IDX = tuple(int(s) for s in np.cumsum(COL_SIZES)[:-1])

kernel_name = "hybrid_streaming_conv_swa_step"


def rms_norm(x, g):
    xf = x.astype(jnp.float32)
    y = xf * lax.rsqrt(jnp.mean(xf * xf, axis=-1, keepdims=True) + EPS)
    return (y * g.astype(jnp.float32)).astype(x.dtype)


def swiglu(x, wg, wu, wd):
    return (jax.nn.silu(x @ wg) * (x @ wu)) @ wd


def t5_bucket(rel):
    nb = N_BUCKETS // 2
    max_exact = nb // 2
    ret = jnp.where(rel > 0, nb, 0)
    n = jnp.abs(rel)
    nf = jnp.maximum(n, 1).astype(jnp.float32)
    large = max_exact + (jnp.log(nf / max_exact) / math.log(MAX_DIST / max_exact) * (nb - max_exact)).astype(jnp.int32)
    large = jnp.minimum(large, nb - 1)
    return ret + jnp.where(n < max_exact, n, large)


def rel_bias(table, n_q, n_k):
    i = jnp.arange(n_q)[:, None]
    j = jnp.arange(n_k)[None, :]
    b = table[t5_bucket(j - WIN_ROWS - i)]
    return b.transpose(2, 0, 1).reshape(N_KV, GROUP, n_q, n_k).astype(jnp.float32)


def sink_softmax(logits, sink):
    s = sink.astype(jnp.float32).reshape(N_KV, GROUP, 1, 1)
    m = jnp.maximum(jnp.max(logits, axis=-1, keepdims=True), s)
    e = jnp.exp(logits - m)
    return e / (jnp.sum(e, axis=-1, keepdims=True) + jnp.exp(s - m))


def short_conv(u, prev, w):
    T = u.shape[1]
    full = jnp.concatenate([prev.astype(u.dtype), u], axis=1)
    out = w[0] * full[:, 0:T]
    for t in range(1, CONV_W):
        out = out + w[t] * full[:, t:t + T]
    return out, full[:, -(CONV_W - 1):]


def swa_prompt(q, k, v, bias, sink):
    B, T = q.shape[:2]
    nc = T // CHUNK
    scale = HEAD_DIM ** -0.5
    qb = q.reshape(B, nc, CHUNK, N_KV, GROUP, HEAD_DIM)
    pad = ((0, 0), (WINDOW, 0), (0, 0), (0, 0))
    kp = jnp.pad(k, pad).reshape(B, nc + N_BAND - 1, CHUNK, N_KV, HEAD_DIM)
    vp = jnp.pad(v, pad).reshape(B, nc + N_BAND - 1, CHUNK, N_KV, HEAD_DIM)
    kb = jnp.concatenate([kp[:, i:i + nc] for i in range(N_BAND)], axis=2)
    vb = jnp.concatenate([vp[:, i:i + nc] for i in range(N_BAND)], axis=2)
    logits = jnp.einsum('bcqkgd,bcskd->bckgqs', qb, kb).astype(jnp.float32) * scale + bias
    key_pos = jnp.arange(nc)[:, None] * CHUNK + jnp.arange(N_BAND * CHUNK)[None, :] - WINDOW
    logits = jnp.where((key_pos >= 0)[None, :, None, None, None, :], logits, NEG)
    p = sink_softmax(logits, sink).astype(v.dtype)
    o = jnp.einsum('bckgqs,bcskd->bcqkgd', p, vb).reshape(B, T, N_HEADS * HEAD_DIM)
    return o, k[:, -WIN_ROWS:], v[:, -WIN_ROWS:]


def swa_sample(q, k, v, k_cache, v_cache, bias, sink):
    B, S = q.shape[:2]
    scale = HEAD_DIM ** -0.5
    qh = q.reshape(B, S, N_KV, GROUP, HEAD_DIM)
    ka = jnp.concatenate([k_cache.astype(k.dtype), k], axis=1)
    va = jnp.concatenate([v_cache.astype(v.dtype), v], axis=1)
    logits = jnp.einsum('bqkgd,bskd->bkgqs', qh, ka).astype(jnp.float32) * scale + bias
    p = sink_softmax(logits, sink).astype(v.dtype)
    o = jnp.einsum('bkgqs,bskd->bqkgd', p, va).reshape(B, S, N_HEADS * HEAD_DIM)
    return o, k, v


def layer(x, pe, conv_prev, attend, w):
    (f1_norm, f1_wg, f1_wu, f1_wd, mix_norm, w_in, conv_w, q_norm, k_norm,
     w_conv_out, w_attn_o, w_out, f2_norm, f2_wg, f2_wu, f2_wd, ple_norm, w_ple, w_ple_gate) = w
    B, T = x.shape[:2]
    h = x + 0.5 * swiglu(rms_norm(x, f1_norm), f1_wg, f1_wu, f1_wd)
    n = rms_norm(h, mix_norm)
    cb, cc, cv, q, k, v, gc, ga = jnp.split(n @ w_in, SPLIT_IDX, axis=-1)
    cu, conv_state = short_conv(cc * cv, conv_prev, conv_w)
    y_conv = (cb * cu) @ w_conv_out
    q = rms_norm(q.reshape(B, T, N_HEADS, HEAD_DIM), q_norm)
    k = rms_norm(k.reshape(B, T, N_KV, HEAD_DIM), k_norm)
    v = v.reshape(B, T, N_KV, HEAD_DIM)
    o, k_state, v_state = attend(q, k, v)
    y_attn = o @ w_attn_o
    h = h + (jax.nn.sigmoid(gc) * y_conv + jax.nn.sigmoid(ga) * y_attn) @ w_out
    h = h + 0.5 * swiglu(rms_norm(h, f2_norm), f2_wg, f2_wu, f2_wd)
    h = h + (pe @ w_ple) * jax.nn.sigmoid(rms_norm(h, ple_norm) @ w_ple_gate)
    return h, conv_state, k_state, v_state


def setup_inputs(seed: int = 0) -> dict:
    key = jax.random.key(seed)
    ks = iter(jax.random.split(key, 40))
    f32 = jnp.float32

    def nrm(shape, scale):
        return jax.random.normal(next(ks), shape, f32) * scale

    def gain(shape):
        return 1.0 + nrm(shape, 0.02)

    L, D = DEPTH, D_MODEL
    return {
        "x_prompt": nrm((BATCH, SEQ, D), 1.0),
        "x_sample": nrm((DEC_BATCH, DEC_SEQ, D), 1.0),
        "p_prompt": nrm((DEPTH, BATCH, SEQ, D_PLE), 1.0),
        "p_sample": nrm((DEPTH, DEC_BATCH, DEC_SEQ, D_PLE), 1.0),
        "state_conv": nrm((DEPTH, DEC_BATCH, CONV_W - 1, D_CONV), 0.5),
        "cache_k": nrm((DEPTH, DEC_BATCH, WIN_ROWS, N_KV, HEAD_DIM), 1.0),
        "cache_v": nrm((DEPTH, DEC_BATCH, WIN_ROWS, N_KV, HEAD_DIM), 1.0),
        "rel_table": nrm((N_BUCKETS, N_HEADS), 0.1),
        "ffn1_norm": gain((L, D)),
        "ffn1_wg": nrm((L, D, D_FF), D ** -0.5),
        "ffn1_wu": nrm((L, D, D_FF), D ** -0.5),
        "ffn1_wd": nrm((L, D_FF, D), D_FF ** -0.5),
        "mix_norm": gain((L, D)),
        "w_in": nrm((L, D, W_IN_COLS), D ** -0.5),
        "conv_w": nrm((L, CONV_W, D_CONV), CONV_W ** -0.5),
        "q_norm": gain((L, HEAD_DIM)),
        "k_norm": gain((L, HEAD_DIM)),
        "attn_sink": nrm((L, N_HEADS), 0.5),
        "w_conv_out": nrm((L, D_CONV, D), D_CONV ** -0.5),
        "w_attn_o": nrm((L, N_HEADS * HEAD_DIM, D), (N_HEADS * HEAD_DIM) ** -0.5),
        "w_out": nrm((L, D, D), D ** -0.5),
        "ffn2_norm": gain((L, D)),
        "ffn2_wg": nrm((L, D, D_FF), D ** -0.5),
        "ffn2_wu": nrm((L, D, D_FF), D ** -0.5),
        "ffn2_wd": nrm((L, D_FF, D), D_FF ** -0.5),
        "ple_norm": gain((L, D)),
        "w_ple": nrm((L, D_PLE, D), D_PLE ** -0.5),
        "w_ple_gate": nrm((L, D, D), D ** -0.5),
    }


def reference(x_prompt, x_sample, p_prompt, p_sample, state_conv, cache_k, cache_v, rel_table,
              ffn1_norm, ffn1_wg, ffn1_wu, ffn1_wd, mix_norm, w_in, conv_w, q_norm, k_norm, attn_sink,
              w_conv_out, w_attn_o, w_out, ffn2_norm, ffn2_wg, ffn2_wu, ffn2_wd, ple_norm, w_ple, w_ple_gate):
    S = x_sample.shape[1]
    bias_p = rel_bias(rel_table, CHUNK, WIN_ROWS + CHUNK)
    bias_s = rel_bias(rel_table, S, WIN_ROWS + S)
    yp, ys = x_prompt, x_sample
    conv_p, k_p, v_p, conv_s, k_s, v_s = [], [], [], [], [], []
    for l in range(DEPTH):
        w = (ffn1_norm[l], ffn1_wg[l], ffn1_wu[l], ffn1_wd[l], mix_norm[l], w_in[l], conv_w[l],
             q_norm[l], k_norm[l], w_conv_out[l], w_attn_o[l], w_out[l],
             ffn2_norm[l], ffn2_wg[l], ffn2_wu[l], ffn2_wd[l], ple_norm[l], w_ple[l], w_ple_gate[l])
        zero_prev = jnp.zeros((yp.shape[0], CONV_W - 1, D_CONV), yp.dtype)
        attend_p = functools.partial(swa_prompt, bias=bias_p, sink=attn_sink[l])
        yp, cs, kk, vv = layer(yp, p_prompt[l], zero_prev, attend_p, w)
        conv_p.append(cs); k_p.append(kk); v_p.append(vv)
        attend_s = functools.partial(swa_sample, k_cache=cache_k[l], v_cache=cache_v[l], bias=bias_s, sink=attn_sink[l])
        ys, cs, kk, vv = layer(ys, p_sample[l], state_conv[l], attend_s, w)
        conv_s.append(cs); k_s.append(kk); v_s.append(vv)
    conv_prompt = jnp.stack(conv_p)
    k_prompt = jnp.stack(k_p)
    v_prompt = jnp.stack(v_p)
    conv_sample = jnp.stack(conv_s)
    k_sample = jnp.stack(k_s)
    v_sample = jnp.stack(v_s)
    return (yp, ys, conv_prompt, k_prompt, v_prompt, conv_sample, k_sample, v_sample)
```

```cpp
#include <hip/hip_runtime.h>
#include <hip/hip_cooperative_groups.h>
#include <cstdio>
#include <cstdint>
namespace cg = cooperative_groups;

#define LAS __attribute__((address_space(3)))
typedef unsigned short bf16_t;
typedef short bf16x8 __attribute__((ext_vector_type(8)));
typedef short s16x4 __attribute__((ext_vector_type(4)));
typedef float f32x2 __attribute__((ext_vector_type(2)));
typedef float f32x4 __attribute__((ext_vector_type(4)));
typedef float f32x16 __attribute__((ext_vector_type(16)));
typedef unsigned u32x2 __attribute__((ext_vector_type(2)));
typedef unsigned u32x4 __attribute__((ext_vector_type(4)));
typedef __bf16 bf2_t __attribute__((ext_vector_type(2)));

constexpr int MP = 16384, MS = 256, M = MP + MS;
constexpr int D = 2048, FF = 4096, DC = 1024, NIN = 8704, DPLE = 256, SEQ = 8192;
constexpr float EPS = 1e-6f;
constexpr size_t O_CONVP = (size_t)M * D, O_KP = O_CONVP + 4096, O_VP = O_KP + 65536, O_CONVS = O_VP + 65536, O_KS = O_CONVS + 32768, O_VS = O_KS + 65536, O_END = O_VS + 65536;
constexpr size_t MiB = 1u << 20;
constexpr size_t WS_CTL = 0, CTL_ZERO_BYTES = 65536; constexpr int CW_BAR = 1024, CW_SPLIT = 8192;
constexpr size_t WS_RMS0 = 512 * 1024;
constexpr size_t WS_SSP1 = 1 * MiB, WS_SSP2 = 4 * MiB, WS_SSP3 = 7 * MiB, WS_PE = 10 * MiB;
constexpr size_t WS_W1 = 20 * MiB, WS_W1D = 52 * MiB, WS_WIN = 68 * MiB, WS_WCO = 102 * MiB, WS_WAO = 106 * MiB, WS_WOUT = 110 * MiB, WS_W2 = 118 * MiB, WS_W2D = 150 * MiB, WS_WPLE = 166 * MiB, WS_WPG = 167 * MiB;
constexpr size_t ACT65 = (size_t)M * D * 2;
constexpr size_t WS_XN = 176 * MiB, WS_CB = WS_XN, WS_U = WS_XN + ACT65 / 2;
constexpr size_t WS_A1 = WS_XN + ACT65, WS_SGC = WS_A1, WS_SGA = WS_A1 + ACT65 / 2, WS_MG = WS_A1 + ACT65, WS_T = WS_XN;
constexpr size_t WS_HB = WS_A1 + 2 * ACT65, WS_CCU = WS_W1, WS_O = WS_W1 + 2 * DC;
constexpr int MIXP = 2048;
constexpr size_t WS_PART = WS_HB + ACT65;
constexpr size_t WS_Q = WS_HB + ACT65, WS_K = WS_Q + ACT65 / 2, WS_V = WS_K + (size_t)M * 256 * 2, WS_END = WS_V + (size_t)M * 256 * 2;

__device__ __forceinline__ unsigned pk2(float a, float b) { f32x2 v = {a, b}; bf2_t r = __builtin_convertvector(v, bf2_t); return __builtin_bit_cast(unsigned, r); }
__device__ __forceinline__ float bflo(unsigned w) { return __builtin_bit_cast(float, w << 16); }
__device__ __forceinline__ float bfhi(unsigned w) { return __builtin_bit_cast(float, w & 0xffff0000u); }
__device__ __forceinline__ float sigmoidf_(float x) { return __builtin_amdgcn_rcpf(1.0f + __expf(-x)); }
__device__ __forceinline__ unsigned q8x4(f32x4 v) { return (unsigned)(v[0] * 255.0f + 0.5f) | ((unsigned)(v[1] * 255.0f + 0.5f) << 8) | ((unsigned)(v[2] * 255.0f + 0.5f) << 16) | ((unsigned)(v[3] * 255.0f + 0.5f) << 24); }
__device__ __forceinline__ void u8x8(u32x2 w, float (&f)[8]) { f[0] = (float)(w.x & 0xffu); f[1] = (float)((w.x >> 8) & 0xffu); f[2] = (float)((w.x >> 16) & 0xffu); f[3] = (float)(w.x >> 24); f[4] = (float)(w.y & 0xffu); f[5] = (float)((w.y >> 8) & 0xffu); f[6] = (float)((w.y >> 16) & 0xffu); f[7] = (float)(w.y >> 24); }

namespace pg8 {
#define PG8_LAS __attribute__((address_space(3)))
constexpr int BM = 256, BK = 64, HALF = 128, HTB = HALF * BK * 2  , STAGE_BYTES = 8 * HTB, NXCD = 8, WGM = 8;

__host__ __device__ __forceinline__ int lds_byte(int r, int c) { const int st = (r >> 4) * 2 + (c >> 5), rr = r & 15, cc = c & 31, ob = rr * 64 + cc * 2; return st * 1024 + (ob ^ (((ob >> 9) & 1) << 5)); }
__host__ __device__ __forceinline__ void stage_rc(int b, int& R, int& C) { const int st = b / 1024, sb = b % 1024, swz = sb ^ (((sb >> 9) & 1) << 5); R = (st >> 1) * 16 + swz / 64; C = (st & 1) * 32 + (swz % 64) / 2; }
__host__ __device__ __forceinline__ int perm32(int rho) { const int n = rho >> 4, i = rho & 15; return 8 * (i >> 2) + 4 * n + (i & 3); }

struct Unit { int pm, pn, kt0, nt, sp; };
struct Gemm { const bf16_t* A; const bf16_t* Bt; int M, N, K; };

struct StaticOrder {
    int nM, nN, nwg, G, c;
    __host__ __device__ void init(int M_, int N_, int G_, int c_) { nM = M_ / BM; nN = N_ / BM; nwg = nM * nN; G = G_; c = c_; }
    __host__ __device__ bool next(int i, Unit& u) const {
        const long L = (long)i * G + c; if (L >= nwg) return false;
        int wgid = (int)L; { const int q = nwg / NXCD, r = nwg % NXCD, xcd = wgid % NXCD, off = wgid / NXCD; wgid = (xcd < r ? xcd * (q + 1) : r * (q + 1) + (xcd - r) * q) + off; }
        const int nig = WGM * nN, gid = wgid / nig, fm = gid * WGM, gsz = (nM - fm) < WGM ? (nM - fm) : WGM;
        u.pm = fm + ((wgid % nig) % gsz); u.pn = (wgid % nig) / gsz; return true;
    }
    __device__ __forceinline__ void a_ready(const Unit&) const {}
    __device__ __forceinline__ void done(const Unit&) const {}
};
struct PhaseOrder {
    int nNp, nwg, nN, S, ntf, c, G; bool lin;
    __device__ __forceinline__ void init(int N_, int K_, int S_, int G_, int c_) { nN = N_ / BM; nNp = nN; nwg = (MP / BM) * nN; S = S_; ntf = K_ / BK; c = c_; G = G_; lin = false; }
    __device__ __forceinline__ bool next(int i, Unit& u) const {
        if (lin) { const int Ll = (c < 64) ? (i == 0 ? c : 1 << 20) : c + 192 * i; u.pm = Ll >> 3; u.pn = Ll & 7; u.sp = -1; u.nt = ntf; u.kt0 = 0; return Ll < (M / BM) * 8; }
        const int L = i * G + c; const bool isP = L < nwg;
        int wgid = isP ? L : 0; { const int q = nwg / NXCD, r = nwg % NXCD, xcd = wgid % NXCD, off = wgid / NXCD; wgid = (xcd < r ? xcd * (q + 1) : r * (q + 1) + (xcd - r) * q) + off; }
        const int nig = WGM * nN, gid = wgid / nig, fm = gid * WGM;
        const int pm = fm + ((wgid % nig) % WGM), pn = (wgid % nig) / WGM;
        const int np = (nwg - c + G - 1) / G;
        const int x = c & 7, ii = c >> 3, j = G - 1 - c; const bool split = S > 1;
        const bool s8 = (S == 8);
        const bool okS = (i == np) && (split ? (s8 ? ii < nN : ii < nN / 2) : (j < nN));
        const int snt = split ? ntf / S : ntf;
        u.pm = isP ? pm : MP / BM; u.pn = isP ? pn : (split ? (s8 ? ii : (nN / 2) * (x >> 2) + ii) : j);
        const int spx = s8 ? x : (x & 3);
        u.sp = (isP || !split) ? -1 : spx; u.nt = isP ? ntf : snt; u.kt0 = (isP || !split) ? 0 : spx * snt;
        return isP || okS;
    }
    __device__ __forceinline__ void a_ready(const Unit&) const {}
    __device__ __forceinline__ void done(const Unit&) const {}
};

enum { MODE_GU = 0, MODE_RES = 1, MODE_IN = 2, MODE_MG2 = 3, MODE_F32 = 5, MODE_OUT = 6 };
struct Epi {
    static constexpr bool PERM = true, AFTER_DRAIN = false;
    int mode; float scale; int step, S, mypm;
    const PG8_LAS float* rtab;
    unsigned char* ws; float* dout;
    unsigned ssp_in_off, ssp_out_off;
    const float* xp; const float* xs;
    const float* qn; const float* kn;

    __device__ __forceinline__ void operator()(f32x4 (&acc)[2][2][4][2], const Unit& u, int wr, int wc, int fr, int fq) const {
        asm volatile("" : "+v"(fr), "+v"(fq));
        const float* ssp_in = ssp_in_off ? (const float*)(ws + ssp_in_off) : nullptr; float* ssp_out = (float*)(ws + ssp_out_off);
        bf16_t* o16 = (bf16_t*)(ws + (mode == MODE_GU ? WS_A1 : WS_HB)); unsigned* cnt = (unsigned*)(ws + WS_CTL) + CW_SPLIT + step * 512;
        int qsel = -1;
        if (u.sp >= 0) {
            typedef unsigned long long u64;
            const int wv = wr * 4 + wc, lane = fq * 16 + fr;
            f32x4* part = (f32x4*)(ws + WS_PART) + ((size_t)(u.pn * S) * 8 + wv) * 2048 + lane;
#pragma unroll
            for (int ai = 0; ai < 2; ++ai)
#pragma unroll
                for (int bj = 0; bj < 2; ++bj)
#pragma unroll
                    for (int m = 0; m < 4; ++m)
#pragma unroll
                        for (int n = 0; n < 2; ++n) {
                            u64* q = (u64*)(part + (size_t)u.sp * 8 * 2048 + (((ai * 2 + bj) * 4 + m) * 2 + n) * 64); const f32x4 v = acc[ai][bj][m][n];
                            __hip_atomic_store(q, ((u64)__float_as_uint(v[1]) << 32) | __float_as_uint(v[0]), __ATOMIC_RELAXED, __HIP_MEMORY_SCOPE_AGENT);
                            __hip_atomic_store(q + 1, ((u64)__float_as_uint(v[3]) << 32) | __float_as_uint(v[2]), __ATOMIC_RELAXED, __HIP_MEMORY_SCOPE_AGENT);
                        }
            asm volatile("s_waitcnt vmcnt(0)" ::: "memory");
            unsigned* cw = cnt + u.pn * 8 + wv;
            if (lane == 0) __hip_atomic_fetch_add(cw, 1u, __ATOMIC_RELAXED, __HIP_MEMORY_SCOPE_AGENT);
            { unsigned spins = 0; while ((unsigned)__builtin_amdgcn_readfirstlane((int)__hip_atomic_load(cw, __ATOMIC_RELAXED, __HIP_MEMORY_SCOPE_AGENT)) < (unsigned)S) { __builtin_amdgcn_s_sleep(2); if (++spins > (1u << 22)) break; } }
            __builtin_amdgcn_fence(__ATOMIC_ACQUIRE, "agent"); asm volatile("s_waitcnt vmcnt(0)" ::: "memory");
            qsel = u.sp;
            if (S == 8) {
                const int qa = qsel >> 2, qm = qsel & 3;
                f32x4 h[2][2][2];
#pragma unroll
                for (int hf = 0; hf < 2; ++hf) {
                    f32x4 t[4][2][2];
#pragma unroll
                    for (int s = 0; s < 4; ++s)
#pragma unroll
                        for (int bj = 0; bj < 2; ++bj)
#pragma unroll
                            for (int n = 0; n < 2; ++n) t[s][bj][n] = part[(size_t)(4 * hf + s) * 8 * 2048 + (((qa * 2 + bj) * 4 + qm) * 2 + n) * 64];
#pragma unroll
                    for (int bj = 0; bj < 2; ++bj)
#pragma unroll
                        for (int n = 0; n < 2; ++n) h[hf][bj][n] = (t[0][bj][n] + t[1][bj][n]) + (t[2][bj][n] + t[3][bj][n]);
                }
#pragma unroll
                for (int bj = 0; bj < 2; ++bj)
#pragma unroll
                    for (int n = 0; n < 2; ++n) { acc[1][bj][0][n] = h[1][bj][n]; acc[0][bj][0][n] = (mode == MODE_MG2) ? h[0][bj][n] : h[0][bj][n] + h[1][bj][n]; }
            } else {
                const int qa = qsel >> 1, qm = (qsel & 1) * 2;
#pragma unroll
                for (int mm = 0; mm < 2; ++mm) {
                    f32x4 t[4][2][2];
#pragma unroll
                    for (int s = 0; s < 4; ++s)
#pragma unroll
                        for (int bj = 0; bj < 2; ++bj)
#pragma unroll
                            for (int n = 0; n < 2; ++n) t[s][bj][n] = part[(size_t)s * 8 * 2048 + (((qa * 2 + bj) * 4 + qm + mm) * 2 + n) * 64];
#pragma unroll
                    for (int bj = 0; bj < 2; ++bj)
#pragma unroll
                        for (int n = 0; n < 2; ++n) {
                            const f32x4 s01 = t[0][bj][n] + t[1][bj][n], s23 = t[2][bj][n] + t[3][bj][n];
                            acc[1][bj][mm][n] = s23;
                            acc[0][bj][mm][n] = (mode == MODE_MG2) ? s01 : s01 + s23;
                        }
                }
            }
        }
        const int mlim = (S == 8) ? 1 : 2;
#define QSKIP(ai, m) if (qsel >= 0 && ((ai) != 0 || (m) >= mlim)) continue
        const int row0 = u.pm * BM + wr * 64 + fr + (qsel < 0 ? 0 : (S == 8 ? (qsel >> 2) * HALF + (qsel & 3) * 16 : (qsel >> 1) * HALF + (qsel & 1) * 32));
        const int cl = wc * 32 + 8 * fq;
        auto rsf = [&](int row) -> float {
            if (!ssp_in) return 1.0f;
            if (u.pm == mypm) return rtab[row & (BM - 1)];
            const float* p = ssp_in + (size_t)row * 32 + 8 * fq;
            const f32x4 a = *(const f32x4*)p, b = *(const f32x4*)(p + 4);
            float s = ((a[0] + a[1]) + (a[2] + a[3])) + ((b[0] + b[1]) + (b[2] + b[3]));
            s += __shfl_xor(s, 16); s += __shfl_xor(s, 32);
            return rsqrtf(s * (1.0f / D) + EPS);
        };
        if (mode == MODE_GU) {
#pragma unroll
            for (int ai = 0; ai < 2; ++ai)
#pragma unroll
                for (int m = 0; m < 4; ++m) {
                    QSKIP(ai, m);
                    const int row = row0 + ai * HALF + m * 16; const float r = rsf(row);
                    float o[8];
#pragma unroll
                    for (int n = 0; n < 2; ++n)
#pragma unroll
                        for (int j = 0; j < 4; ++j) { const float g = acc[ai][0][m][n][j] * r, uu = acc[ai][1][m][n][j] * r; o[4 * n + j] = g * sigmoidf_(g) * uu; }
                    u32x4 w; w.x = pk2(o[0], o[1]); w.y = pk2(o[2], o[3]); w.z = pk2(o[4], o[5]); w.w = pk2(o[6], o[7]);
                    *(u32x4*)(o16 + (size_t)row * FF + u.pn * HALF + cl) = w;
                }
        } else if (mode == MODE_RES) {
            const bf16_t* xb = xp ? (const bf16_t*)(ws + WS_XN) : o16;
            const float* rms0 = (const float*)(ws + WS_RMS0);
#pragma unroll
            for (int ai = 0; ai < 2; ++ai) {
                if (qsel >= 0 && ai != 0) continue;
                f32x4 bb[4][2][2];
#pragma unroll
                for (int m = 0; m < 4; ++m) {
                    if (qsel >= 0 && m >= mlim) continue;
                    const size_t off = (size_t)(row0 + ai * HALF + m * 16) * D + u.pn * BM + cl;
#pragma unroll
                    for (int bj = 0; bj < 2; ++bj) {
                        const u32x4 hb = *(const u32x4*)(xb + off + bj * HALF); bb[m][bj][0] = (f32x4){bflo(hb.x), bfhi(hb.x), bflo(hb.y), bfhi(hb.y)}; bb[m][bj][1] = (f32x4){bflo(hb.z), bfhi(hb.z), bflo(hb.w), bfhi(hb.w)};
                    }
                }
#pragma unroll
                for (int m = 0; m < 4; ++m) {
                    QSKIP(ai, m);
                    const int row = row0 + ai * HALF + m * 16; const size_t off = (size_t)row * D + u.pn * BM + cl; float ss = 0.f;
                    const float bs = xp ? (u.pm == mypm ? rtab[BM + (row & (BM - 1))] : rms0[row]) : 1.0f;
#pragma unroll
                    for (int bj = 0; bj < 2; ++bj) {
                        const f32x4 v0 = bb[m][bj][0] * bs + acc[ai][bj][m][0] * scale, v1 = bb[m][bj][1] * bs + acc[ai][bj][m][1] * scale;
                        u32x4 w; w.x = pk2(v0[0], v0[1]); w.y = pk2(v0[2], v0[3]); w.z = pk2(v1[0], v1[1]); w.w = pk2(v1[2], v1[3]);
                        *(u32x4*)(o16 + off + bj * HALF) = w;
                        ss += (v0[0] * v0[0] + v0[1] * v0[1]) + (v0[2] * v0[2] + v0[3] * v0[3]) + (v1[0] * v1[0] + v1[1] * v1[1]) + (v1[2] * v1[2] + v1[3] * v1[3]);
                    }
                    ss += __shfl_xor(ss, 16); ss += __shfl_xor(ss, 32);
                    if (fq == 0) ssp_out[(size_t)row * 32 + u.pn * 4 + wc] = ss;
                }
            }
        } else if (mode == MODE_IN) {
            const int pn = u.pn;
            if (pn >= 4 && pn < 12) {
                bf16_t* U = (bf16_t*)(ws + WS_U);
#pragma unroll
                for (int ai = 0; ai < 2; ++ai)
#pragma unroll
                    for (int m = 0; m < 4; ++m) {
                    QSKIP(ai, m);
                        const int row = row0 + ai * HALF + m * 16; const float r_ = rsf(row), r2 = r_ * r_; const int col = (pn - 4) * HALF + cl;
                        const f32x4 v0 = acc[ai][0][m][0] * acc[ai][1][m][0] * r2, v1 = acc[ai][0][m][1] * acc[ai][1][m][1] * r2;
                        u32x4 w; w.x = pk2(v0[0], v0[1]); w.y = pk2(v0[2], v0[3]); w.z = pk2(v1[0], v1[1]); w.w = pk2(v1[2], v1[3]);
                        *(u32x4*)(U + (size_t)row * DC + col) = w;
                        float* cs = nullptr;
                        if (row < MP) { const int t = row & (SEQ - 1); if (t >= SEQ - 2) cs = dout + O_CONVP + ((size_t)(row >> 13) * 2 + (t - (SEQ - 2))) * DC + col; }
                        else { const int t = row & 15; if (t >= 14) cs = dout + O_CONVS + ((size_t)((row - MP) >> 4) * 2 + (t - 14)) * DC + col; }
                        if (cs) { *(f32x4*)cs = v0; *(f32x4*)(cs + 4) = v1; }
                    }
            } else if (pn >= 12 && pn < 17) {
                const bool isk = (pn == 16); const float* gn = isk ? kn : qn;
                f32x4 gv[2][2];
#pragma unroll
                for (int bj = 0; bj < 2; ++bj) { gv[bj][0] = *(const f32x4*)(gn + 32 * bj + 8 * fq); gv[bj][1] = *(const f32x4*)(gn + 32 * bj + 8 * fq + 4); }
                bf16_t* O = isk ? (bf16_t*)(ws + WS_K) : (bf16_t*)(ws + WS_Q); const int ldo = isk ? 256 : 1024; const int hcol = (isk ? wc : 4 * (pn - 12) + wc) * 64 + 8 * fq;
#pragma unroll
                for (int ai = 0; ai < 2; ++ai)
#pragma unroll
                    for (int m = 0; m < 4; ++m) {
                    QSKIP(ai, m);
                        const int row = row0 + ai * HALF + m * 16; const float r = rsf(row);
                        f32x4 v[2][2]; float ss = 0.f;
#pragma unroll
                        for (int bj = 0; bj < 2; ++bj)
#pragma unroll
                            for (int n = 0; n < 2; ++n) { v[bj][n] = acc[ai][bj][m][n] * r; ss += (v[bj][n][0] * v[bj][n][0] + v[bj][n][1] * v[bj][n][1]) + (v[bj][n][2] * v[bj][n][2] + v[bj][n][3] * v[bj][n][3]); }
                        ss += __shfl_xor(ss, 16); ss += __shfl_xor(ss, 32);
                        const float hr = rsqrtf(ss * (1.0f / 64.0f) + EPS);
                        float* fo = nullptr;
                        if (isk) { if (row >= MP) fo = dout + O_KS + (size_t)(row - MP) * 256 + wc * 64 + 8 * fq;
                                   else { const int t = row & (SEQ - 1); if (t >= SEQ - 128) fo = dout + O_KP + ((size_t)(row >> 13) * 128 + (t - (SEQ - 128))) * 256 + wc * 64 + 8 * fq; } }
#pragma unroll
                        for (int bj = 0; bj < 2; ++bj) {
                            const f32x4 o0 = v[bj][0] * hr * gv[bj][0], o1 = v[bj][1] * hr * gv[bj][1];
                            u32x4 w; w.x = pk2(o0[0], o0[1]); w.y = pk2(o0[2], o0[3]); w.z = pk2(o1[0], o1[1]); w.w = pk2(o1[2], o1[3]);
                            *(u32x4*)(O + (size_t)row * ldo + hcol + 32 * bj) = w;
                            if (fo) { *(f32x4*)(fo + 32 * bj) = o0; *(f32x4*)(fo + 32 * bj + 4) = o1; }
                        }
                    }
            } else {
                bf16_t* O; int ldo, colt; bool sg = false, isv = false;
                if (pn < 4) { O = (bf16_t*)(ws + WS_CB); ldo = DC; colt = pn * BM; }
                else if (pn == 17) { O = (bf16_t*)(ws + WS_V); ldo = 256; colt = 0; isv = true; }
                else if (pn < 26) { O = (bf16_t*)(ws + WS_SGC); ldo = D; colt = (pn - 18) * BM; sg = true; }
                else { O = (bf16_t*)(ws + WS_SGA); ldo = D; colt = (pn - 26) * BM; sg = true; }
#pragma unroll
                for (int ai = 0; ai < 2; ++ai)
#pragma unroll
                    for (int m = 0; m < 4; ++m) {
                    QSKIP(ai, m);
                        const int row = row0 + ai * HALF + m * 16; const float r = rsf(row);
                        float* fo = nullptr;
                        if (isv) { if (row >= MP) fo = dout + O_VS + (size_t)(row - MP) * 256 + cl;
                                   else { const int t = row & (SEQ - 1); if (t >= SEQ - 128) fo = dout + O_VP + ((size_t)(row >> 13) * 128 + (t - (SEQ - 128))) * 256 + cl; } }
#pragma unroll
                        for (int bj = 0; bj < 2; ++bj) {
                            f32x4 v0 = acc[ai][bj][m][0] * r, v1 = acc[ai][bj][m][1] * r;
                            if (sg) {
#pragma unroll
                                for (int j = 0; j < 4; ++j) { v0[j] = sigmoidf_(v0[j]); v1[j] = sigmoidf_(v1[j]); } }
                            if (sg) { u32x2 q; q.x = q8x4(v0); q.y = q8x4(v1); *(u32x2*)((unsigned char*)O + (size_t)row * D + colt + bj * HALF + cl) = q; }
                            else { u32x4 w; w.x = pk2(v0[0], v0[1]); w.y = pk2(v0[2], v0[3]); w.z = pk2(v1[0], v1[1]); w.w = pk2(v1[2], v1[3]);
                                *(u32x4*)(O + (size_t)row * ldo + colt + bj * HALF + cl) = w; }
                            if (fo) { *(f32x4*)(fo + bj * HALF) = v0; *(f32x4*)(fo + bj * HALF + 4) = v1; }
                        }
                    }
            }
        } else if (mode == MODE_MG2) {
            const unsigned char* SGC = (const unsigned char*)(ws + WS_SGC); const unsigned char* SGA = (const unsigned char*)(ws + WS_SGA); bf16_t* MG = (bf16_t*)(ws + WS_MG);
#pragma unroll
            for (int ai = 0; ai < 2; ++ai) {
                if (qsel >= 0 && ai != 0) continue;
                u32x2 sa[4][2], sc[4][2];
#pragma unroll
                for (int m = 0; m < 4; ++m) {
                    if (qsel >= 0 && m >= mlim) continue;
#pragma unroll
                    for (int bj = 0; bj < 2; ++bj) { const size_t off = (size_t)(row0 + ai * HALF + m * 16) * D + u.pn * BM + bj * HALF + cl; sa[m][bj] = *(const u32x2*)(SGA + off); if (qsel >= 0) sc[m][bj] = *(const u32x2*)(SGC + off); }
                }
#pragma unroll
                for (int m = 0; m < 4; ++m) {
                    QSKIP(ai, m);
                    const int row = row0 + ai * HALF + m * 16;
#pragma unroll
                    for (int bj = 0; bj < 2; ++bj) {
                        const size_t off = (size_t)row * D + u.pn * BM + bj * HALF + cl;
                        float ga[8]; u8x8(sa[m][bj], ga);
                        const f32x4 a0 = acc[ai][bj][m][0], a1 = acc[ai][bj][m][1];
                        float o[8];
                        if (qsel >= 0) {
                            float gc[8]; u8x8(sc[m][bj], gc); const f32x4 b0 = acc[1][bj][m][0], b1 = acc[1][bj][m][1];
#pragma unroll
                            for (int j = 0; j < 4; ++j) { o[j] = (a0[j] * gc[j] + b0[j] * ga[j]) * (1.0f / 255.0f); o[4 + j] = (a1[j] * gc[4 + j] + b1[j] * ga[4 + j]) * (1.0f / 255.0f); }
                        } else {
#pragma unroll
                            for (int j = 0; j < 4; ++j) { o[j] = a0[j] * (fmaxf(ga[j], 0.5f) * (1.0f / 255.0f)); o[4 + j] = a1[j] * (fmaxf(ga[4 + j], 0.5f) * (1.0f / 255.0f)); }
                        }
                        u32x4 w; w.x = pk2(o[0], o[1]); w.y = pk2(o[2], o[3]); w.z = pk2(o[4], o[5]); w.w = pk2(o[6], o[7]);
                        *(u32x4*)(MG + off) = w;
                    }
                }
            }
        } else {
            bf16_t* T = (bf16_t*)(ws + WS_T); const bf16_t* HBp = (const bf16_t*)(ws + WS_HB); const bool fin = (mode == MODE_OUT);
#pragma unroll
            for (int ai = 0; ai < 2; ++ai) {
                if (qsel >= 0 && ai != 0) continue;
                u32x4 tt[4][2], hh[4][2];
                if (fin) {
#pragma unroll
                    for (int m = 0; m < 4; ++m) {
                        if (qsel >= 0 && m >= mlim) continue;
#pragma unroll
                        for (int bj = 0; bj < 2; ++bj) { const size_t off = (size_t)(row0 + ai * HALF + m * 16) * D + u.pn * BM + bj * HALF + cl; tt[m][bj] = *(const u32x4*)(T + off); hh[m][bj] = *(const u32x4*)(HBp + off); }
                    }
                }
#pragma unroll
                for (int m = 0; m < 4; ++m) {
                    QSKIP(ai, m);
                    const int row = row0 + ai * HALF + m * 16; const float r = rsf(row);
#pragma unroll
                    for (int bj = 0; bj < 2; ++bj) {
                        const size_t off = (size_t)row * D + u.pn * BM + bj * HALF + cl;
                        f32x4 v0 = acc[ai][bj][m][0], v1 = acc[ai][bj][m][1];
                        if (fin) {
                            const u32x4 t = tt[m][bj], hb = hh[m][bj]; const f32x4 h0 = {bflo(hb.x), bfhi(hb.x), bflo(hb.y), bfhi(hb.y)}, h1 = {bflo(hb.z), bfhi(hb.z), bflo(hb.w), bfhi(hb.w)};
                            const f32x4 t0 = {bflo(t.x), bfhi(t.x), bflo(t.y), bfhi(t.y)}, t1 = {bflo(t.z), bfhi(t.z), bflo(t.w), bfhi(t.w)};
#pragma unroll
                            for (int j = 0; j < 4; ++j) { v0[j] = h0[j] + t0[j] * sigmoidf_(v0[j] * r); v1[j] = h1[j] + t1[j] * sigmoidf_(v1[j] * r); }
                            *(f32x4*)(dout + off) = v0; *(f32x4*)(dout + off + 4) = v1;
                        } else { u32x4 w; w.x = pk2(v0[0], v0[1]); w.y = pk2(v0[2], v0[3]); w.z = pk2(v1[0], v1[1]); w.w = pk2(v1[2], v1[3]); *(u32x4*)(T + off) = w; }
                    }
                }
            }
        }
    }
#undef QSKIP
    __device__ __forceinline__ void mid(f32x4 (&acc)[2][2][4][2], const Unit& u, int wr, int wc, int fr, int fq) const {
        asm volatile("" : "+v"(fr), "+v"(fq));
        const unsigned char* SGC = (const unsigned char*)(ws + WS_SGC); const unsigned char* SGA = (const unsigned char*)(ws + WS_SGA);
        const int row0 = u.pm * BM + wr * 64 + fr, cl = wc * 32 + 8 * fq;
        u32x2 cc[2][4][2], ss[2][4][2];
#pragma unroll
        for (int ai = 0; ai < 2; ++ai)
#pragma unroll
            for (int m = 0; m < 4; ++m)
#pragma unroll
                for (int bj = 0; bj < 2; ++bj) { const size_t off = (size_t)(row0 + ai * HALF + m * 16) * D + u.pn * BM + bj * HALF + cl; cc[ai][m][bj] = *(const u32x2*)(SGC + off); ss[ai][m][bj] = *(const u32x2*)(SGA + off); }
#pragma unroll
        for (int ai = 0; ai < 2; ++ai)
#pragma unroll
            for (int m = 0; m < 4; ++m)
#pragma unroll
                for (int bj = 0; bj < 2; ++bj) {
                    float gc[8], ga[8]; u8x8(cc[ai][m][bj], gc); u8x8(ss[ai][m][bj], ga);
#pragma unroll
                    for (int j = 0; j < 4; ++j) { acc[ai][bj][m][0][j] *= gc[j] * __builtin_amdgcn_rcpf(fmaxf(ga[j], 0.5f)); acc[ai][bj][m][1][j] *= gc[4 + j] * __builtin_amdgcn_rcpf(fmaxf(ga[4 + j], 0.5f)); }
                }
    }
};

template <class Epi, class Sched, bool ALIGN_EPI = false, bool SP2 = false>
__device__ __forceinline__ void gemm_phase(PG8_LAS unsigned char* lds, const Gemm g, const Sched& S, const Epi& E) {
    const int tid = threadIdx.x, wid = __builtin_amdgcn_readfirstlane(tid >> 6), lane = tid & 63, wr = wid >> 2, wc = wid & 3, fr = lane & 15, fq = lane >> 4;
    const int K = g.K;
    unsigned voffA[2], voffB[2];
#pragma unroll
    for (int i = 0; i < 2; ++i) { int R, C; stage_rc(tid * 16 + i * 8192, R, C); const int Rb = Epi::PERM ? ((R & ~31) + perm32(R & 31)) : R;
        voffA[i] = (unsigned)(R * K + C) * 2u; voffB[i] = (unsigned)(Rb * K + C) * 2u; }
    const size_t kstep = (size_t)(BK * 2);
    const size_t hstep = (size_t)HALF * K * 2;
    const size_t tstep = 2 * hstep;
    const unsigned ldsw = (unsigned)wid * 1024u;
    const int aoff = lds_byte(wr * 64 + fr, fq * 8), boff = lds_byte(wc * 32 + fr, fq * 8);
#define PG8_SA(b, h) (((b) * 2 + (h)) * HTB)
#define PG8_SB(b, h) ((4 + (b) * 2 + (h)) * HTB)
#define PG8_STAGE(bufoff, gbase, voff) do { _Pragma("unroll") for (int _i = 0; _i < 2; ++_i) \
        __builtin_amdgcn_global_load_lds((const unsigned*)((const char*)(gbase) + (voff)[_i]), (PG8_LAS unsigned*)(lds + (bufoff) + ldsw + _i * 8192), 16, 0, 0); } while (0)
#define PG8_LDA(dst, b, h) do { _Pragma("unroll") for (int m = 0; m < 4; ++m) _Pragma("unroll") for (int k = 0; k < 2; ++k) dst[m][k] = *(const PG8_LAS bf16x8*)(lds + PG8_SA(b, h) + aoff + m * 2048 + k * 1024); } while (0)
#define PG8_LDB(dst, b, h) do { _Pragma("unroll") for (int n = 0; n < 2; ++n) _Pragma("unroll") for (int k = 0; k < 2; ++k) dst[n][k] = *(const PG8_LAS bf16x8*)(lds + PG8_SB(b, h) + boff + n * 2048 + k * 1024); } while (0)
#define PG8_MMA(ai, bj, At, Bt) do { __builtin_amdgcn_s_setprio(1); _Pragma("unroll") for (int m = 0; m < 4; ++m) _Pragma("unroll") for (int n = 0; n < 2; ++n) _Pragma("unroll") for (int k = 0; k < 2; ++k) \
        acc[ai][bj][m][n] = __builtin_amdgcn_mfma_f32_16x16x32_bf16(Bt[n][k], At[m][k], acc[ai][bj][m][n], 0, 0, 0); __builtin_amdgcn_s_setprio(0); } while (0)
#define PG8_WAIT_V(n) asm volatile("s_waitcnt vmcnt(" #n ")" ::: "memory")
#define PG8_WAIT_L(n) asm volatile("s_waitcnt lgkmcnt(" #n ")" ::: "memory")
#define PG8_BAR __builtin_amdgcn_s_barrier()
#define PG8_SCHED __builtin_amdgcn_sched_barrier(0)
    Unit cur, nxt; int ui = 0;
    if (!S.next(0, cur)) return;
    f32x4 acc[2][2][4][2];
#pragma unroll
    for (int a = 0; a < 2; ++a)
#pragma unroll
        for (int b = 0; b < 2; ++b)
#pragma unroll
            for (int m = 0; m < 4; ++m)
#pragma unroll
                for (int n = 0; n < 2; ++n) acc[a][b][m][n] = (f32x4){0.f, 0.f, 0.f, 0.f};
    bf16x8 At[4][2], B0[2][2], B1[2][2];
    const char* cA = (const char*)g.A + (size_t)cur.pm * tstep + (size_t)cur.kt0 * kstep; const char* cB = (const char*)g.Bt + (size_t)cur.pn * tstep + (size_t)cur.kt0 * kstep;
    S.a_ready(cur);
    if constexpr (SP2) {
        PG8_STAGE(PG8_SB(0, 0), cB, voffB); PG8_STAGE(PG8_SB(0, 1), cB + hstep, voffB); PG8_STAGE(PG8_SA(0, 0), cA, voffA); PG8_STAGE(PG8_SA(0, 1), cA + hstep, voffA);
        if (wr == 1) PG8_BAR;
        PG8_WAIT_V(2); PG8_BAR;
        PG8_STAGE(PG8_SB(1, 0), cB + kstep, voffB); PG8_STAGE(PG8_SA(1, 0), cA + kstep, voffA); PG8_STAGE(PG8_SB(1, 1), cB + hstep + kstep, voffB);
        PG8_WAIT_V(6); PG8_BAR;
    } else {
        PG8_STAGE(PG8_SB(0, 0), cB, voffB); PG8_STAGE(PG8_SA(0, 0), cA, voffA); PG8_STAGE(PG8_SB(0, 1), cB + hstep, voffB); PG8_STAGE(PG8_SA(0, 1), cA + hstep, voffA);
        if (wr == 1) PG8_BAR;
        PG8_WAIT_V(4); PG8_BAR;
        PG8_STAGE(PG8_SB(1, 0), cB + kstep, voffB); PG8_STAGE(PG8_SA(1, 0), cA + kstep, voffA); PG8_STAGE(PG8_SB(1, 1), cB + hstep + kstep, voffB);
        PG8_WAIT_V(6); PG8_BAR;
    }
    for (;;) {
        const bool has_next = S.next(ui + 1, nxt);
        const char* nA = has_next ? (const char*)g.A + (size_t)nxt.pm * tstep + (size_t)nxt.kt0 * kstep : cA; const char* nB = has_next ? (const char*)g.Bt + (size_t)nxt.pn * tstep + (size_t)nxt.kt0 * kstep : cB;
        const int nt = cur.nt;
        for (int t = 0; t < nt; t += 2) {
            const bool last = (t == nt - 2);
            const char* a1 = cA + (size_t)(t + 1) * kstep;
            const char* a2 = last ? nA : cA + (size_t)(t + 2) * kstep; const char* b2 = last ? nB : cB + (size_t)(t + 2) * kstep;
            const char* a3 = a2 + kstep; const char* b3 = b2 + kstep;
            if (last && has_next) S.a_ready(nxt);
            if (E.mode == MODE_MG2 && cur.sp < 0 && t == (nt >> 1)) E.mid(acc, cur, wr, wc, fr, fq);
            if constexpr (SP2) {
            PG8_LDB(B0, 0, 0); PG8_LDB(B1, 0, 1); PG8_SCHED; PG8_LDA(At, 0, 0); PG8_STAGE(PG8_SA(1, 1), a1 + hstep, voffA);
            PG8_WAIT_V(8); PG8_WAIT_L(0); PG8_BAR; PG8_MMA(0, 0, At, B0); PG8_MMA(0, 1, At, B1); PG8_BAR; PG8_SCHED;
            PG8_LDA(At, 0, 1); PG8_STAGE(PG8_SB(0, 0), b2, voffB); PG8_STAGE(PG8_SB(0, 1), b2 + hstep, voffB); PG8_STAGE(PG8_SA(0, 0), a2, voffA);
            PG8_WAIT_V(8); PG8_WAIT_L(0); PG8_BAR; PG8_MMA(1, 0, At, B0); PG8_MMA(1, 1, At, B1); PG8_BAR; PG8_SCHED;
            PG8_LDB(B0, 1, 0); PG8_LDB(B1, 1, 1); PG8_SCHED; PG8_LDA(At, 1, 0); PG8_STAGE(PG8_SA(0, 1), a2 + hstep, voffA);
            PG8_WAIT_V(8); PG8_WAIT_L(0); PG8_BAR; PG8_MMA(0, 0, At, B0); PG8_MMA(0, 1, At, B1); PG8_BAR; PG8_SCHED;
            PG8_LDA(At, 1, 1); PG8_STAGE(PG8_SB(1, 0), b3, voffB); PG8_STAGE(PG8_SB(1, 1), b3 + hstep, voffB); PG8_STAGE(PG8_SA(1, 0), a3, voffA);
            PG8_WAIT_V(8); PG8_WAIT_L(0); PG8_BAR; PG8_MMA(1, 0, At, B0); PG8_MMA(1, 1, At, B1); PG8_BAR; PG8_SCHED;
            } else {
            PG8_LDB(B0, 0, 0); PG8_SCHED; PG8_LDA(At, 0, 0); PG8_STAGE(PG8_SA(1, 1), a1 + hstep, voffA);
            PG8_WAIT_L(8); PG8_BAR; PG8_WAIT_L(0); PG8_MMA(0, 0, At, B0); PG8_BAR; PG8_SCHED;
            PG8_LDB(B1, 0, 1); PG8_STAGE(PG8_SB(0, 0), b2, voffB);
            PG8_BAR; PG8_WAIT_L(0); PG8_MMA(0, 1, At, B1); PG8_BAR;
            PG8_LDA(At, 0, 1); PG8_STAGE(PG8_SA(0, 0), a2, voffA);
            PG8_BAR; PG8_WAIT_L(0); PG8_MMA(1, 0, At, B0); PG8_BAR; PG8_SCHED;
            PG8_STAGE(PG8_SB(0, 1), b2 + hstep, voffB);
            PG8_WAIT_V(6); PG8_BAR; PG8_MMA(1, 1, At, B1); PG8_BAR;
            PG8_LDB(B0, 1, 0); PG8_SCHED; PG8_LDA(At, 1, 0); PG8_STAGE(PG8_SA(0, 1), a2 + hstep, voffA);
            PG8_WAIT_L(8); PG8_BAR; PG8_WAIT_L(0); PG8_MMA(0, 0, At, B0); PG8_BAR; PG8_SCHED;
            PG8_LDB(B1, 1, 1); PG8_STAGE(PG8_SB(1, 0), b3, voffB);
            PG8_BAR; PG8_WAIT_L(0); PG8_MMA(0, 1, At, B1); PG8_BAR;
            PG8_LDA(At, 1, 1); PG8_STAGE(PG8_SA(1, 0), a3, voffA);
            PG8_BAR; PG8_WAIT_L(0); PG8_MMA(1, 0, At, B0); PG8_BAR; PG8_SCHED;
            PG8_STAGE(PG8_SB(1, 1), b3 + hstep, voffB);
            PG8_WAIT_V(6); PG8_BAR; PG8_MMA(1, 1, At, B1); PG8_BAR;
            }
        }
        if constexpr (ALIGN_EPI) { if (wr == 0) PG8_BAR; }
        if constexpr (!Epi::AFTER_DRAIN) { E(acc, cur, wr, wc, fr, fq); S.done(cur); }
        if (!has_next) break;
#pragma unroll
        for (int a = 0; a < 2; ++a)
#pragma unroll
            for (int b = 0; b < 2; ++b)
#pragma unroll
                for (int m = 0; m < 4; ++m)
#pragma unroll
                    for (int n = 0; n < 2; ++n) acc[a][b][m][n] = (f32x4){0.f, 0.f, 0.f, 0.f};
        cur = nxt; cA = nA; cB = nB; ++ui;
        if constexpr (ALIGN_EPI) { if (wr == 1) PG8_BAR; }
    }
    PG8_WAIT_V(0);
    if constexpr (!ALIGN_EPI) { if (wr == 0) PG8_BAR; }
    PG8_BAR;
    if constexpr (Epi::AFTER_DRAIN) { E.fused(acc, cur, wr, wc, fr, fq, lds, wid, lane); S.done(cur); }
#undef PG8_SA
#undef PG8_SB
#undef PG8_STAGE
#undef PG8_LDA
#undef PG8_LDB
#undef PG8_MMA
#undef PG8_WAIT_V
#undef PG8_WAIT_L
#undef PG8_BAR
#undef PG8_SCHED
}}

struct Args { const float* in[28]; float* out; unsigned char* ws; int lo, hi; };
enum { I_XP = 0, I_XS, I_PP, I_PS, I_SCONV, I_CK, I_CV, I_REL, I_F1N, I_F1G, I_F1U, I_F1D, I_MIXN, I_WIN, I_CONVW, I_QN, I_KN, I_SINK, I_WCO, I_WAO, I_WOUT, I_F2N, I_F2G, I_F2U, I_F2D, I_PLEN, I_WPLE, I_WPG };
constexpr int NWAVES = 8, NTHR = 512;
#define RLX_AGENT __ATOMIC_RELAXED, __HIP_MEMORY_SCOPE_AGENT
constexpr int RING_BYTES = 131072, MISC_OFF = 134144, LDS_BYTES = 135168;

__device__ __forceinline__ void tr_item(const float* src, int srcN, int colA, int colB, const float* gain, int K, bf16_t* dst, int drow0, int k0, LAS float* scr, int lane, int kd0 = -1) {
    if (kd0 < 0) kd0 = k0;
    const float* sp = src + (size_t)k0 * srcN + ((lane < 32) ? colA + lane : colB + lane - 32);
    const float g = gain ? gain[k0 + lane] : 1.0f;
    float v[64];
#pragma unroll
    for (int kk = 0; kk < 64; ++kk) v[kk] = sp[(size_t)kk * srcN];
#pragma unroll
    for (int kk = 0; kk < 64; ++kk) scr[kk * 65 + lane] = v[kk] * __builtin_bit_cast(float, __builtin_amdgcn_readlane(__builtin_bit_cast(int, g), kk));
    asm volatile("s_waitcnt lgkmcnt(0)" ::: "memory");
    const int c = lane & 7;
#pragma unroll
    for (int j = 0; j < 8; ++j) { const int n = (lane >> 3) + 8 * j; const LAS float* s = scr + (8 * c) * 65 + n;
        u32x4 o; o.x = pk2(s[0 * 65], s[1 * 65]); o.y = pk2(s[2 * 65], s[3 * 65]); o.z = pk2(s[4 * 65], s[5 * 65]); o.w = pk2(s[6 * 65], s[7 * 65]);
        *(u32x4*)(dst + (size_t)(drow0 + n) * K + kd0 + 8 * c) = o; }
    asm volatile("s_waitcnt lgkmcnt(0)" ::: "memory");
}
__device__ __forceinline__ float wave_sum(float v) {
#pragma unroll
    for (int o = 1; o < 64; o <<= 1) v += __shfl_xor(v, o);
    return v;
}
__device__ __forceinline__ int win_col(int n0) {
    const int pn = n0 >> 8, r = n0 & 255;
    if (pn < 4) return n0;
    if (pn < 12) return ((r >> 7) ? 2048 : 1024) + 128 * (pn - 4) + (r & 127);
    if (pn < 16) return 3072 + 64 * (4 * (pn - 12) + ((r >> 5) & 3)) + 32 * (r >> 7);
    if (pn == 16) return 4096 + 64 * ((r >> 5) & 3) + 32 * (r >> 7);
    if (pn == 17) return 4352 + r;
    if (pn < 26) return 4608 + 256 * (pn - 18) + r;
    return 6656 + 256 * (pn - 26) + r;
}
enum { J_W1 = 0, J_W1D, J_WIN, J_WCO, J_WAO, J_WOUT, J_W2, J_W2D, J_WPLE, J_WPG };
__device__ __forceinline__ int job_items(int j) { return j == J_W1 || j == J_W2 ? 32 * 128 : j == J_W1D || j == J_W2D ? 64 * 32 : j == J_WIN ? 32 * 136 : j == J_WCO || j == J_WAO ? 16 * 32 : j == J_WPLE ? 4 * 32 : 32 * 32; }
__device__ __forceinline__ void job_item(const Args& a, int j, int r, LAS float* scr, int lane) {
    unsigned char* ws = a.ws;
    if (j == J_W1 || j == J_W2) { const int kb = r / 128, n0 = (r % 128) * 64; const int pn = n0 >> 8, rr = n0 & 255, c0 = 128 * pn + (rr & 127); const bool f2 = (j == J_W2);
        tr_item((rr >> 7) ? a.in[f2 ? I_F2U : I_F1U] : a.in[f2 ? I_F2G : I_F1G], FF, c0, c0 + 32, a.in[f2 ? I_F2N : I_F1N], D, (bf16_t*)(ws + (f2 ? WS_W2 : WS_W1)), n0, kb * 64, scr, lane); }
    else if (j == J_WIN) { const int kb = r / 136, n0 = (r % 136) * 64; tr_item(a.in[I_WIN], NIN, win_col(n0), win_col(n0 + 32), a.in[I_MIXN], D, (bf16_t*)(ws + WS_WIN), n0, kb * 64, scr, lane); }
    else { const int kb = r / 32, n0 = (r % 32) * 64;
        const float* src; const float* gain = nullptr; int K; size_t dst; int kd = kb * 64;
        if (j == J_W1D) { src = a.in[I_F1D]; K = FF; dst = WS_W1D; } else if (j == J_W2D) { src = a.in[I_F2D]; K = FF; dst = WS_W2D; }
        else if (j == J_WCO) { src = a.in[I_WCO]; K = MIXP; dst = WS_WCO; } else if (j == J_WAO) { src = a.in[I_WAO]; K = MIXP; dst = WS_WCO; kd += DC; }
        else if (j == J_WOUT) { src = a.in[I_WOUT]; K = D; dst = WS_WOUT; } else if (j == J_WPLE) { src = a.in[I_WPLE]; K = DPLE; dst = WS_WPLE; }
        else { src = a.in[I_WPG]; K = D; dst = WS_WPG; gain = a.in[I_PLEN]; }
        tr_item(src, D, n0, n0 + 32, gain, K, (bf16_t*)(ws + dst), n0, kb * 64, scr, lane, kd); }
}
__device__ __forceinline__ void convert_jobs(const Args& a, int j0, int j1, int w, int nw, LAS unsigned char* lds, int wave, int lane) {
    LAS float* scr = (LAS float*)(lds + wave * 16640);
    int base = 0;
    for (int j = j0; j < j1; ++j) { const int ni = job_items(j);
        for (int it = (w + nw - (base % nw)) % nw; it < ni; it += nw) job_item(a, j, it, scr, lane);
        base += ni; }
}
__device__ __forceinline__ void prologue(const Args& a, LAS unsigned char* lds, int gw, int NGW, int wave, int lane) {
    unsigned char* ws = a.ws;
    if (NGW == 256 * NWAVES) {
        convert_jobs(a, J_W1, J_W1 + 1, gw, NGW, lds, wave, lane);
        convert_jobs(a, J_WPLE, J_WPG + 1, gw, NGW, lds, wave, lane);
    } else convert_jobs(a, J_W1, J_WPG + 1, gw, NGW, lds, wave, lane);
    auto xrow = [&](int m) -> const float* { return (m < MP) ? a.in[I_XP] + (size_t)m * D : a.in[I_XS] + (size_t)(m - MP) * D; };
    auto prow = [&](int m) -> const float* { return (m < MP) ? a.in[I_PP] + (size_t)m * DPLE : a.in[I_PS] + (size_t)(m - MP) * DPLE; };
    auto finish = [&](int m, const f32x4 (&v)[8], const f32x4& p) {
        float s = 0.f;
#pragma unroll
        for (int j = 0; j < 8; ++j) s += (v[j][0] * v[j][0] + v[j][1] * v[j][1]) + (v[j][2] * v[j][2] + v[j][3] * v[j][3]);
        const float ms = wave_sum(s) * (1.0f / D) + EPS; const float rstd = rsqrtf(ms);
        if (lane == 0) ((float*)(ws + WS_RMS0))[m] = sqrtf(ms);
        u32x2* o = (u32x2*)((bf16_t*)(ws + WS_XN) + (size_t)m * D);
#pragma unroll
        for (int j = 0; j < 8; ++j) { u32x2 w; w.x = pk2(v[j][0] * rstd, v[j][1] * rstd); w.y = pk2(v[j][2] * rstd, v[j][3] * rstd); o[lane + 64 * j] = w; }
        u32x2 w; w.x = pk2(p[0], p[1]); w.y = pk2(p[2], p[3]);
        ((u32x2*)((bf16_t*)(ws + WS_PE) + (size_t)m * DPLE))[lane] = w;
    };
    for (int m = gw; m < M; m += 2 * NGW) {
        const int m2 = m + NGW; const bool two = m2 < M;
        f32x4 v1[8], v2[8], p1, p2;
        const float* x1 = xrow(m); const float* x2 = xrow(two ? m2 : m);
#pragma unroll
        for (int j = 0; j < 8; ++j) v1[j] = ((const f32x4*)x1)[lane + 64 * j];
#pragma unroll
        for (int j = 0; j < 8; ++j) v2[j] = ((const f32x4*)x2)[lane + 64 * j];
        p1 = ((const f32x4*)prow(m))[lane]; p2 = ((const f32x4*)prow(two ? m2 : m))[lane];
        finish(m, v1, p1);
        if (two) finish(m2, v2, p2);
    }
}

constexpr int KS_STRIDE = 144, VT_STRIDE = 400, ATT_KS = 0, ATT_VT = 28672, ATT_LUT = 55296;
__device__ __forceinline__ int t5_bucket(int rel) {
    const int n = rel < 0 ? -rel : rel; int b = rel > 0 ? 16 : 0;
    if (n < 8) return b + n;
    int lg = 8 + (31 - __builtin_clz((unsigned)(n * n))) - 6; if (lg > 15) lg = 15;
    return b + lg;
}
__device__ __forceinline__ void attn_conv_phase(const Args& a, LAS unsigned char* lds) {
    int tid = threadIdx.x; asm volatile("" : "+v"(tid));
    const int lane = tid & 63, wave = __builtin_amdgcn_readfirstlane(tid >> 6);
    unsigned char* ws = a.ws;
    const bf16_t* Qb = (const bf16_t*)(ws + WS_Q); bf16_t* Ob = (bf16_t*)(ws + WS_O); const bf16_t* Kb = (const bf16_t*)(ws + WS_K); const bf16_t* Vb = (const bf16_t*)(ws + WS_V);
    LAS bf16_t* Ks = (LAS bf16_t*)(lds + ATT_KS); LAS bf16_t* Vt = (LAS bf16_t*)(lds + ATT_VT); LAS float* lut = (LAS float*)(lds + ATT_LUT);
    const int g = wave >> 1, qh = wave & 1, q = lane & 31, h = lane >> 5;
    for (int uid = blockIdx.x; uid < 1024 + 64; uid += gridDim.x) {
        const bool smp = uid >= 1024; int b, c, kvh;
        if (!smp) { kvh = uid & 3; c = (uid >> 2) & 127; b = uid >> 9; } else { const int s = uid - 1024; kvh = s & 3; b = s >> 2; c = 0; }
        auto ldrow = [&](bool isv, int j, int ck) -> u32x4 {
            u32x4 w = {0u, 0u, 0u, 0u};
            if (!smp) { const int pos = 64 * (c - 2) + j; if (pos >= 0) w = *(const u32x4*)((isv ? Vb : Kb) + (size_t)(b * SEQ + pos) * 256 + kvh * 64 + 8 * ck); }
            else if (j < 128) { const float* cp = a.in[isv ? I_CV : I_CK] + ((size_t)(b * 128 + j) * 4 + kvh) * 64 + 8 * ck; const f32x4 x0 = *(const f32x4*)cp, x1 = *(const f32x4*)(cp + 4);
                w.x = pk2(x0[0], x0[1]); w.y = pk2(x0[2], x0[3]); w.z = pk2(x1[0], x1[1]); w.w = pk2(x1[2], x1[3]); }
            else if (j < 144) w = *(const u32x4*)((isv ? Vb : Kb) + (size_t)(MP + b * 16 + (j - 128)) * 256 + kvh * 64 + 8 * ck);
            return w; };
        u32x4 kw[3], vw[4];
#pragma unroll
        for (int i = 0; i < 3; ++i) { const int idx = tid + i * NTHR; kw[i] = ldrow(false, idx >> 3, idx & 7); }
        const int vjg = tid >> 3, vck = tid & 7;
        if (tid < 384) {
#pragma unroll
            for (int i = 0; i < 4; ++i) vw[i] = ldrow(true, 4 * vjg + i, vck); }
#pragma unroll
        for (int i = 0; i < 3; ++i) { const int idx = tid + i * NTHR; *(LAS u32x4*)((LAS unsigned char*)Ks + (idx >> 3) * KS_STRIDE + (idx & 7) * 16) = kw[i]; }
        if (tid < 384) {
            LAS unsigned char* vp = (LAS unsigned char*)Vt + (8 * vck) * VT_STRIDE + 8 * vjg;
#pragma unroll
            for (int e = 0; e < 4; ++e) {
                const unsigned w0 = e == 0 ? vw[0].x : e == 1 ? vw[0].y : e == 2 ? vw[0].z : vw[0].w, w1 = e == 0 ? vw[1].x : e == 1 ? vw[1].y : e == 2 ? vw[1].z : vw[1].w;
                const unsigned w2 = e == 0 ? vw[2].x : e == 1 ? vw[2].y : e == 2 ? vw[2].z : vw[2].w, w3 = e == 0 ? vw[3].x : e == 1 ? vw[3].y : e == 2 ? vw[3].z : vw[3].w;
                u32x2 lo, hi; lo.x = (w0 & 0xffffu) | (w1 << 16); lo.y = (w2 & 0xffffu) | (w3 << 16); hi.x = (w0 >> 16) | (w1 & 0xffff0000u); hi.y = (w2 >> 16) | (w3 & 0xffff0000u);
                *(LAS u32x2*)(vp + (2 * e) * VT_STRIDE) = lo; *(LAS u32x2*)(vp + (2 * e + 1) * VT_STRIDE) = hi;
            }
        }
        for (int idx = tid; idx < 1024; idx += NTHR) { const int gg = idx >> 8, r = idx & 255; lut[idx] = a.in[I_REL][t5_bucket(r - 191) * 16 + 4 * kvh + gg] * 1.44269504f; }
        const int iq = smp ? (q & 15) : 32 * qh + q;
        const size_t qrow = smp ? (size_t)(MP + b * 16 + iq) : (size_t)(b * SEQ + 64 * c + iq);
        const bf16_t* qp = Qb + qrow * 1024 + (4 * kvh + g) * 64; bf16_t* op = Ob + qrow * MIXP + (4 * kvh + g) * 64;
        bf16x8 qf[4];
#pragma unroll
        for (int s = 0; s < 4; ++s) qf[s] = *(const bf16x8*)(qp + 16 * s + 8 * h);
        const float sink = a.in[I_SINK][4 * kvh + g] * 1.44269504f;
        __syncthreads();
        if (!(smp && qh)) {
            f32x16 st[6];
#pragma unroll
            for (int kt = 0; kt < 6; ++kt) {
#pragma unroll
                for (int i = 0; i < 16; ++i) st[kt][i] = 0.f;
#pragma unroll
                for (int s = 0; s < 4; ++s) {
                    const bf16x8 kf = *(const LAS bf16x8*)((const LAS unsigned char*)Ks + (32 * kt + q) * KS_STRIDE + (16 * s + 8 * h) * 2);
                    st[kt] = __builtin_amdgcn_mfma_f32_32x32x16_bf16(kf, qf[s], st[kt], 0, 0, 0);
                }
            }
            const int kmin = smp ? 0 : (c >= 2 ? 0 : 128 - 64 * c), kmax = smp ? 144 : 192; const bool need_mask = smp || c < 2;
#pragma unroll
            for (int kt = 0; kt < 6; ++kt)
#pragma unroll
                for (int i = 0; i < 16; ++i) { const int key = 32 * kt + 8 * (i >> 2) + 4 * h + (i & 3); st[kt][i] = st[kt][i] * (0.125f * 1.44269504f) + lut[g * 256 + key - iq + 63]; }
            if (need_mask) {
#pragma unroll
                for (int kt = 0; kt < 6; ++kt)
#pragma unroll
                    for (int i = 0; i < 16; ++i) { const int key = 32 * kt + 8 * (i >> 2) + 4 * h + (i & 3); if (key < kmin || key >= kmax) st[kt][i] = -1e30f; }
            }
            float mx = -3.0e38f;
#pragma unroll
            for (int kt = 0; kt < 6; ++kt)
#pragma unroll
                for (int i = 0; i < 16; ++i) mx = fmaxf(mx, st[kt][i]);
            mx = fmaxf(mx, __shfl_xor(mx, 32)); mx = fmaxf(mx, sink);
            float l = 0.f;
#pragma unroll
            for (int kt = 0; kt < 6; ++kt)
#pragma unroll
                for (int i = 0; i < 16; ++i) { const float e = __builtin_amdgcn_exp2f(st[kt][i] - mx); st[kt][i] = e; l += e; }
            l += __shfl_xor(l, 32); l += __builtin_amdgcn_exp2f(sink - mx);
            f32x16 ot[2];
#pragma unroll
            for (int i = 0; i < 16; ++i) { ot[0][i] = 0.f; ot[1][i] = 0.f; }
#pragma unroll
            for (int kt = 0; kt < 6; ++kt)
#pragma unroll
                for (int s = 0; s < 2; ++s) {
                    u32x4 pw; pw.x = pk2(st[kt][8 * s + 0], st[kt][8 * s + 1]); pw.y = pk2(st[kt][8 * s + 2], st[kt][8 * s + 3]); pw.z = pk2(st[kt][8 * s + 4], st[kt][8 * s + 5]); pw.w = pk2(st[kt][8 * s + 6], st[kt][8 * s + 7]);
                    const bf16x8 pf = __builtin_bit_cast(bf16x8, pw);
#pragma unroll
                    for (int dt = 0; dt < 2; ++dt) {
                        const LAS unsigned char* vp = (const LAS unsigned char*)Vt + (32 * dt + q) * VT_STRIDE + (32 * kt + 16 * s + 4 * h) * 2;
                        const s16x4 lo = *(const LAS s16x4*)vp, hi = *(const LAS s16x4*)(vp + 16);
                        const bf16x8 vf = {lo[0], lo[1], lo[2], lo[3], hi[0], hi[1], hi[2], hi[3]};
                        ot[dt] = __builtin_amdgcn_mfma_f32_32x32x16_bf16(vf, pf, ot[dt], 0, 0, 0);
                    }
                }
            const float inv = 1.0f / l;
            if (!smp || q < 16) {
#pragma unroll
                for (int dt = 0; dt < 2; ++dt)
#pragma unroll
                    for (int gq = 0; gq < 4; ++gq) {
                        u32x2 w; w.x = pk2(ot[dt][4 * gq + 0] * inv, ot[dt][4 * gq + 1] * inv); w.y = pk2(ot[dt][4 * gq + 2] * inv, ot[dt][4 * gq + 3] * inv);
                        *(u32x2*)(op + 32 * dt + 8 * gq + 4 * h) = w;
                    }
            }
        }
        __syncthreads();
    }
    {
        const bf16_t* CB = (const bf16_t*)(ws + WS_CB); bf16_t* CCU = (bf16_t*)(ws + WS_CCU); const bf16_t* U = (const bf16_t*)(ws + WS_U);
        const int ch = (tid & 127) * 8;
        float w0[8], w1[8], w2[8];
#pragma unroll
        for (int e = 0; e < 8; ++e) { w0[e] = a.in[I_CONVW][ch + e]; w1[e] = a.in[I_CONVW][DC + ch + e]; w2[e] = a.in[I_CONVW][2 * DC + ch + e]; }
        int rbeg, rend;
        if (gridDim.x == 256) { const int cc = blockIdx.x; if (cc < 64) { rbeg = cc * 44; rend = rbeg + 44; } else { rbeg = 64 * 44 + (cc - 64) * 72; rend = rbeg + 72; } }
        else { const int per = (M + gridDim.x - 1) / gridDim.x; rbeg = blockIdx.x * per; rend = rbeg + per < M ? rbeg + per : M; }
#pragma unroll 2
        for (int row = rbeg + (tid >> 7); row < rend; row += 4) {
            int t, bb; const bool smp = row >= MP;
            if (!smp) { t = row & (SEQ - 1); bb = row >> 13; } else { t = row & 15; bb = (row - MP) >> 4; }
            const u32x4 cb = *(const u32x4*)(CB + (size_t)row * DC + ch), u0 = *(const u32x4*)(U + (size_t)row * DC + ch);
            float p1[8], p2[8];
            if (t >= 1) { const u32x4 x = *(const u32x4*)(U + (size_t)(row - 1) * DC + ch); p1[0] = bflo(x.x); p1[1] = bfhi(x.x); p1[2] = bflo(x.y); p1[3] = bfhi(x.y); p1[4] = bflo(x.z); p1[5] = bfhi(x.z); p1[6] = bflo(x.w); p1[7] = bfhi(x.w); }
            else if (smp) { const float* sp = a.in[I_SCONV] + ((size_t)bb * 2 + 1) * DC + ch;
#pragma unroll
                for (int e = 0; e < 8; ++e) p1[e] = sp[e]; }
            else {
#pragma unroll
                for (int e = 0; e < 8; ++e) p1[e] = 0.f; }
            if (t >= 2) { const u32x4 x = *(const u32x4*)(U + (size_t)(row - 2) * DC + ch); p2[0] = bflo(x.x); p2[1] = bfhi(x.x); p2[2] = bflo(x.y); p2[3] = bfhi(x.y); p2[4] = bflo(x.z); p2[5] = bfhi(x.z); p2[6] = bflo(x.w); p2[7] = bfhi(x.w); }
            else if (smp) { const float* sp = a.in[I_SCONV] + ((size_t)bb * 2 + t) * DC + ch;
#pragma unroll
                for (int e = 0; e < 8; ++e) p2[e] = sp[e]; }
            else {
#pragma unroll
                for (int e = 0; e < 8; ++e) p2[e] = 0.f; }
            float uc[8] = {bflo(u0.x), bfhi(u0.x), bflo(u0.y), bfhi(u0.y), bflo(u0.z), bfhi(u0.z), bflo(u0.w), bfhi(u0.w)};
            float cf[8] = {bflo(cb.x), bfhi(cb.x), bflo(cb.y), bfhi(cb.y), bflo(cb.z), bfhi(cb.z), bflo(cb.w), bfhi(cb.w)};
            float o[8];
#pragma unroll
            for (int e = 0; e < 8; ++e) o[e] = cf[e] * (w0[e] * p2[e] + w1[e] * p1[e] + w2[e] * uc[e]);
            u32x4 w; w.x = pk2(o[0], o[1]); w.y = pk2(o[2], o[3]); w.z = pk2(o[4], o[5]); w.w = pk2(o[6], o[7]);
            *(u32x4*)(CCU + (size_t)row * MIXP + ch) = w;
        }
    }
}

#define XB_TMO      128
#define XB_XCNT(j)  (256  + 64 * (j))
#define XB_XSUB(j)  (1280 + 64 * (j))
#define XB_XGEN(j)  (2304 + 64 * (j))
#define XB_TOP      3328
#define XB_TOPGEN   3392
#define XCD_BAR_WORDS 3456
#define XB_SPIN_CAP (1u << 18)

__device__ __forceinline__ unsigned xb_ld(unsigned* p)              { return __hip_atomic_load(p, __ATOMIC_RELAXED, __HIP_MEMORY_SCOPE_AGENT); }
__device__ __forceinline__ unsigned xb_add(unsigned* p, unsigned v) { return __hip_atomic_fetch_add(p, v, __ATOMIC_RELAXED, __HIP_MEMORY_SCOPE_AGENT); }
__device__ __forceinline__ unsigned xb_xcc_id() { return (unsigned)__builtin_amdgcn_s_getreg((3 << 11) | 20) & 0xFu; }
#define XB_SPIN(cond, bar) do { unsigned _sp = 0; while (cond) { __builtin_amdgcn_s_sleep(1); \
    if ((++_sp & 255u) == 0u) { if (xb_ld(&(bar)[XB_TMO])) break; if (_sp > XB_SPIN_CAP) { atomicAdd(&(bar)[XB_TMO], 1u); break; } } } } while (0)

struct XcdBarrier {
    unsigned* bar; unsigned x;
    volatile LAS unsigned* st;
};

__device__ __forceinline__ XcdBarrier xcd_barrier_post(unsigned* bar, volatile LAS unsigned* st) {
    XcdBarrier b; b.bar = bar; b.x = xb_xcc_id(); b.st = st;
    if (threadIdx.x == 0) (void)xb_add(&bar[XB_XCNT(b.x)], 1u);
    return b;
}
__device__ __forceinline__ void xcd_barrier_complete(unsigned* bar, unsigned x, unsigned& nloc, unsigned& nx) {
    const unsigned G = gridDim.x * gridDim.y * gridDim.z;
    unsigned sum, cnt, mine, sp = 0u;
    for (;;) {
        sum = 0u; cnt = 0u; mine = 0u;
#pragma unroll
        for (unsigned j = 0; j < 16; ++j) { const unsigned c = xb_ld(&bar[XB_XCNT(j)]); sum += c; cnt += (c > 0u) ? 1u : 0u; mine = (j == x) ? c : mine; }
        if (sum == G) break;
        __builtin_amdgcn_s_sleep(1);
        if ((++sp & 255u) == 0u) { if (xb_ld(&bar[XB_TMO])) break; if (sp > XB_SPIN_CAP) { atomicAdd(&bar[XB_TMO], 1u); break; } }
    }
    nloc = mine > 0u ? mine : 1u; nx = cnt > 0u ? cnt : 1u;
}

__device__ __forceinline__ void xcd_barrier(const XcdBarrier& b) {
    asm volatile("s_waitcnt vmcnt(0)" ::: "memory");
    __syncthreads();
    if (threadIdx.x == 0) {
        unsigned* bar = b.bar;
        __builtin_amdgcn_s_waitcnt(0);
        unsigned nloc = b.st[0], nx = b.st[1];
        if (nloc == 0u) { xcd_barrier_complete(bar, b.x, nloc, nx); b.st[0] = nloc; b.st[1] = nx; }
        const unsigned old = xb_add(&bar[XB_XSUB(b.x)], 1u);
        const unsigned gen = old / nloc;
        if (old + 1u == (gen + 1u) * nloc) {
            __builtin_amdgcn_fence(__ATOMIC_RELEASE, "agent");
            asm volatile("s_waitcnt vmcnt(0)" ::: "memory");
            const unsigned og = xb_add(&bar[XB_TOP], 1u);
            const unsigned tg = og / nx;
            if (og + 1u == (tg + 1u) * nx) xb_add(&bar[XB_TOPGEN], 1u);
            else XB_SPIN(xb_ld(&bar[XB_TOPGEN]) == tg, bar);
            __builtin_amdgcn_fence(__ATOMIC_ACQUIRE, "agent");
            xb_add(&bar[XB_XGEN(b.x)], 1u);
            asm volatile("s_waitcnt vmcnt(0)" ::: "memory");
        } else {
            XB_SPIN(xb_ld(&bar[XB_XGEN(b.x)]) == gen, bar);
            __builtin_amdgcn_fence(__ATOMIC_ACQUIRE, "agent");
            asm volatile("s_waitcnt vmcnt(0)" ::: "memory");
        }
    }
    __syncthreads();
}

constexpr int NSTEPS = 12;
__global__ void __launch_bounds__(NTHR, 2) fwd_kernel(Args args) {
    extern __shared__ __attribute__((aligned(16))) unsigned char lds_raw[];
    LAS unsigned char* lds = (LAS unsigned char*)lds_raw;
    const int tid = threadIdx.x, lane = tid & 63, wave = __builtin_amdgcn_readfirstlane(tid >> 6);
    const int G = gridDim.x;
    unsigned char* ws = args.ws;
    volatile LAS unsigned* MISC = (volatile LAS unsigned*)(lds + MISC_OFF);
    if (tid < 64) MISC[tid] = 0u;
    __syncthreads();
    const bool one_launch = (args.hi - args.lo) > 1;
    XcdBarrier xbar; xbar.bar = (unsigned*)(ws + WS_CTL) + CW_BAR; xbar.x = 0; xbar.st = nullptr;
    if (one_launch) xbar = xcd_barrier_post((unsigned*)(ws + WS_CTL) + CW_BAR, MISC + 8);
    if (args.lo < 0) cg::this_grid().sync();
#define SEAM(step, sync_after) do { if ((step) + 1 < args.hi) { if (sync_after) xcd_barrier(xbar); else { asm volatile("s_waitcnt vmcnt(0)" ::: "memory"); __syncthreads(); } } } while (0)
    if (args.lo <= 0 && 0 < args.hi) {
        const int vcu = (G % 8 == 0) ? (blockIdx.x % 8) * (G / 8) + blockIdx.x / 8 : blockIdx.x;
        prologue(args, lds, vcu * NWAVES + wave, G * NWAVES, wave, lane);
        SEAM(0, true);
    }
    for (int step = (args.lo > 1 ? args.lo : 1); step < (args.hi < 4 ? args.hi : 4); ++step) {
        pg8::Gemm g; pg8::Epi E;
        E.ws = ws; E.dout = args.out; E.scale = 1.f; E.ssp_in_off = 0; E.ssp_out_off = 0; E.step = step; E.xp = nullptr; E.xs = nullptr; E.qn = args.in[I_QN]; E.kn = args.in[I_KN];
        g.M = M;
        if (step == 1) { g.A = (const bf16_t*)(ws + WS_XN); g.Bt = (const bf16_t*)(ws + WS_W1); g.N = 2 * FF; g.K = D; E.mode = pg8::MODE_GU; }
        else if (step == 2) { g.A = (const bf16_t*)(ws + WS_A1); g.Bt = (const bf16_t*)(ws + WS_W1D); g.N = D; g.K = FF; E.mode = pg8::MODE_RES; E.scale = 0.5f; E.xp = args.in[I_XP]; E.xs = args.in[I_XS];
                 E.ssp_out_off = (unsigned)WS_SSP1; }
        else { g.A = (const bf16_t*)(ws + WS_HB); g.Bt = (const bf16_t*)(ws + WS_WIN); g.N = NIN; g.K = D; E.mode = pg8::MODE_IN; E.ssp_in_off = (unsigned)WS_SSP1; }
        E.mypm = -1; E.rtab = (const LAS float*)(lds + RING_BYTES);
        if ((E.ssp_in_off || E.xp) && G == 256) {
            const int c_ = (int)blockIdx.x, pmq = 8 * (c_ & 7) + ((c_ >> 3) & 7); int t_ = threadIdx.x; asm volatile("" : "+v"(t_));
            if (E.xp && t_ >= 256) ((LAS float*)(lds + RING_BYTES))[t_] = ((const float*)(ws + WS_RMS0))[pmq * 256 + t_ - 256];
            if (E.ssp_in_off && t_ < 256) { const float* p_ = (const float*)(ws + E.ssp_in_off) + (size_t)(pmq * 256 + t_) * 32; float s_ = 0.f;
#pragma unroll
                for (int k_ = 0; k_ < 8; ++k_) { const f32x4 a_ = ((const f32x4*)p_)[k_]; s_ += (a_[0] + a_[1]) + (a_[2] + a_[3]); }
                ((LAS float*)(lds + RING_BYTES))[t_] = rsqrtf(s_ * (1.0f / D) + EPS); }
            __syncthreads(); E.mypm = pmq;
        }
        pg8::PhaseOrder S; const int nsplit = (step == 3) ? 1 : (g.N == D ? 8 : 4); E.S = nsplit; S.init(g.N, g.K, nsplit, G, (int)blockIdx.x);
        pg8::gemm_phase<pg8::Epi, pg8::PhaseOrder, true, true>(lds, g, S, E);
        {
            const int c = (int)blockIdx.x; int tlane = threadIdx.x; asm volatile("" : "+v"(tlane)); tlane &= 63;
            if (G != 256) {} else if (step == 1 && c >= 128) convert_jobs(args, J_W1D, J_W1D + 1, (c - 128) * NWAVES + wave, 128 * NWAVES, lds, wave, tlane);
            else if (step == 2 && c >= 64) convert_jobs(args, J_WIN, J_WIN + 1, (c - 64) * NWAVES + wave, 192 * NWAVES, lds, wave, tlane);
            else if (step == 3 && c >= 128 && c < 222) convert_jobs(args, J_WCO, J_WOUT + 1, (c - 128) * NWAVES + wave, 94 * NWAVES, lds, wave, tlane);
        }
        SEAM(step, true);
    }
    if (args.lo <= 4 && 4 < args.hi) {
        attn_conv_phase(args, lds);
        SEAM(4, true);
    }
    for (int step = (args.lo > 5 ? args.lo : 5); step < args.hi; ++step) {
        if (step == 6) continue;
        bool sync_after = true;
        pg8::Gemm g; pg8::Epi E;
        E.ws = ws; E.dout = args.out; E.scale = 1.f; E.ssp_in_off = 0; E.ssp_out_off = 0; E.step = step; E.xp = nullptr; E.xs = nullptr; E.qn = nullptr; E.kn = nullptr;
        g.M = M;
        switch (step) {
        case 5:  g.A = (const bf16_t*)(ws + WS_CCU); g.Bt = (const bf16_t*)(ws + WS_WCO); g.N = D; g.K = MIXP; E.mode = pg8::MODE_MG2; break;
        case 7:  g.A = (const bf16_t*)(ws + WS_MG); g.Bt = (const bf16_t*)(ws + WS_WOUT); g.N = D; g.K = D; E.mode = pg8::MODE_RES; E.ssp_out_off = (unsigned)WS_SSP2; break;
        case 8:  g.A = (const bf16_t*)(ws + WS_HB); g.Bt = (const bf16_t*)(ws + WS_W2); g.N = 2 * FF; g.K = D; E.mode = pg8::MODE_GU; E.ssp_in_off = (unsigned)WS_SSP2; break;
        case 9:  g.A = (const bf16_t*)(ws + WS_A1); g.Bt = (const bf16_t*)(ws + WS_W2D); g.N = D; g.K = FF; E.mode = pg8::MODE_RES; E.scale = 0.5f; E.ssp_out_off = (unsigned)WS_SSP3; sync_after = false; break;
        case 10: g.A = (const bf16_t*)(ws + WS_PE); g.Bt = (const bf16_t*)(ws + WS_WPLE); g.N = D; g.K = DPLE; E.mode = pg8::MODE_F32; break;
        default: g.A = (const bf16_t*)(ws + WS_HB); g.Bt = (const bf16_t*)(ws + WS_WPG); g.N = D; g.K = D; E.mode = pg8::MODE_OUT; E.ssp_in_off = (unsigned)WS_SSP3; break;
        }
        E.mypm = -1; E.rtab = (const LAS float*)(lds + RING_BYTES);
        if ((E.ssp_in_off || E.xp) && G == 256) {
            const int c_ = (int)blockIdx.x, pmq = 8 * (c_ & 7) + ((c_ >> 3) & 7); int t_ = threadIdx.x; asm volatile("" : "+v"(t_));
            if (E.xp && t_ >= 256) ((LAS float*)(lds + RING_BYTES))[t_] = ((const float*)(ws + WS_RMS0))[pmq * 256 + t_ - 256];
            if (E.ssp_in_off && t_ < 256) { const float* p_ = (const float*)(ws + E.ssp_in_off) + (size_t)(pmq * 256 + t_) * 32; float s_ = 0.f;
#pragma unroll
                for (int k_ = 0; k_ < 8; ++k_) { const f32x4 a_ = ((const f32x4*)p_)[k_]; s_ += (a_[0] + a_[1]) + (a_[2] + a_[3]); }
                ((LAS float*)(lds + RING_BYTES))[t_] = rsqrtf(s_ * (1.0f / D) + EPS); }
            __syncthreads(); E.mypm = pmq;
        }
        pg8::PhaseOrder S; const int nsplit = (step == 10) ? 1 : (g.N == D ? 8 : 4); E.S = nsplit; S.init(g.N, g.K, nsplit, G, (int)blockIdx.x); S.lin = (step == 10 && G == 256);
        pg8::gemm_phase<pg8::Epi, pg8::PhaseOrder, true, true>(lds, g, S, E);
        {   const int c = (int)blockIdx.x; int tlane = threadIdx.x; asm volatile("" : "+v"(tlane)); tlane &= 63;
            if (G != 256) {} else if (step == 5 && c >= 64) convert_jobs(args, J_W2, J_W2 + 1, (c - 64) * NWAVES + wave, 192 * NWAVES, lds, wave, tlane);
            else if (step == 8 && c >= 128) convert_jobs(args, J_W2D, J_W2D + 1, (c - 128) * NWAVES + wave, 128 * NWAVES, lds, wave, tlane);
        }
        SEAM(step, sync_after);
    }
#undef SEAM
}

#ifndef N_LAUNCHES
#define N_LAUNCHES 1
#endif
extern "C" void kernel_launch(void* const* d_in, const int* in_sizes, int n_in, void* d_out, int out_size, void* d_ws, size_t ws_size, hipStream_t stream) {
    static int grid = 0;
    if (grid == 0) {
        if (n_in != 28 || (size_t)out_size != O_END || ws_size < WS_END) { fprintf(stderr, "kernel_launch: unexpected shapes: n_in %d out %d ws %zu (need %zu)\n", n_in, out_size, ws_size, (size_t)WS_END); grid = -1; return; }
        int dev = 0, cus = 0, per_cu = 0;
        hipGetDevice(&dev); hipDeviceGetAttribute(&cus, hipDeviceAttributeMultiprocessorCount, dev);
        if (hipFuncSetAttribute((const void*)fwd_kernel, hipFuncAttributeMaxDynamicSharedMemorySize, LDS_BYTES) != hipSuccess) { fprintf(stderr, "kernel_launch: hipFuncSetAttribute failed\n"); grid = -1; return; }
        if (hipOccupancyMaxActiveBlocksPerMultiprocessor(&per_cu, (const void*)fwd_kernel, NTHR, LDS_BYTES) != hipSuccess || per_cu < 1) { fprintf(stderr, "kernel_launch: occupancy query says %d\n", per_cu); per_cu = 1; }
        (void)hipGetLastError();
        grid = cus * 1;
        if (grid <= 0) grid = 256;
    }
    if (grid < 0) return;
    Args a{};
    for (int i = 0; i < 28; ++i) a.in[i] = (const float*)d_in[i];
    a.out = (float*)d_out; a.ws = (unsigned char*)d_ws;
#if N_LAUNCHES == 1
    if (hipMemsetAsync((char*)d_ws + WS_CTL, 0, CTL_ZERO_BYTES, stream) != hipSuccess) { fprintf(stderr, "kernel_launch: memset failed\n"); return; }
    a.lo = 0; a.hi = NSTEPS;
    void* kargs[] = {&a};
    hipError_t e = hipLaunchCooperativeKernel((const void*)fwd_kernel, dim3(grid), dim3(NTHR), kargs, LDS_BYTES, stream);
    if (e != hipSuccess) fprintf(stderr, "kernel_launch: cooperative launch failed: %s (grid %d)\n", hipGetErrorString(e), grid);
#else
    for (int s = 0; s < NSTEPS; ++s) { a.lo = s; a.hi = s + 1; hipLaunchKernelGGL(fwd_kernel, dim3(grid), dim3(NTHR), LDS_BYTES, stream, a); }
#endif
}
```

```cpp
#include <hip/hip_runtime.h>
#include <hip/hip_cooperative_groups.h>
#include <cstdio>
#include <cstdint>
namespace cg = cooperative_groups;

#define LAS __attribute__((address_space(3)))
typedef unsigned short bf16_t;
typedef short bf16x8 __attribute__((ext_vector_type(8)));
typedef short s16x4 __attribute__((ext_vector_type(4)));
typedef float f32x2 __attribute__((ext_vector_type(2)));
typedef float f32x4 __attribute__((ext_vector_type(4)));
typedef float f32x16 __attribute__((ext_vector_type(16)));
typedef unsigned u32x2 __attribute__((ext_vector_type(2)));
typedef unsigned u32x4 __attribute__((ext_vector_type(4)));
typedef __bf16 bf2_t __attribute__((ext_vector_type(2)));

constexpr int MP = 16384, MS = 256, M = MP + MS;
constexpr int D = 2048, FF = 4096, DC = 1024, NIN = 8704, DPLE = 256, SEQ = 8192;
constexpr float EPS = 1e-6f;
constexpr size_t O_CONVP = (size_t)M * D, O_KP = O_CONVP + 4096, O_VP = O_KP + 65536, O_CONVS = O_VP + 65536, O_KS = O_CONVS + 32768, O_VS = O_KS + 65536, O_END = O_VS + 65536;
constexpr size_t MiB = 1u << 20;
constexpr size_t WS_CTL = 0, CTL_ZERO_BYTES = 65536; constexpr int CW_BAR = 1024, CW_SPLIT = 8192;
constexpr size_t WS_RMS0 = 512 * 1024;
constexpr size_t WS_SSP1 = 1 * MiB, WS_SSP2 = 4 * MiB, WS_SSP3 = 7 * MiB, WS_PE = 10 * MiB;
constexpr size_t WS_W1 = 20 * MiB, WS_W1D = 52 * MiB, WS_WIN = 68 * MiB, WS_WCO = 102 * MiB, WS_WAO = 106 * MiB, WS_WOUT = 110 * MiB, WS_W2 = 118 * MiB, WS_W2D = 150 * MiB, WS_WPLE = 166 * MiB, WS_WPG = 167 * MiB;
constexpr size_t ACT65 = (size_t)M * D * 2;
constexpr size_t WS_XN = 176 * MiB, WS_CB = WS_XN, WS_U = WS_XN + ACT65 / 2;
constexpr size_t WS_A1 = WS_XN + ACT65, WS_SGC = WS_A1, WS_SGA = WS_A1 + ACT65 / 2, WS_MG = WS_A1 + ACT65, WS_T = WS_XN;
constexpr size_t WS_HB = WS_A1 + 2 * ACT65, WS_CCU = WS_W1, WS_O = WS_W1 + 2 * DC;
constexpr int MIXP = 2048;
constexpr size_t WS_PART = WS_HB + ACT65;
constexpr size_t WS_Q = WS_HB + ACT65, WS_K = WS_Q + ACT65 / 2, WS_V = WS_K + (size_t)M * 256 * 2, WS_END = WS_V + (size_t)M * 256 * 2;

__device__ __forceinline__ unsigned pk2(float a, float b) { f32x2 v = {a, b}; bf2_t r = __builtin_convertvector(v, bf2_t); return __builtin_bit_cast(unsigned, r); }
__device__ __forceinline__ float bflo(unsigned w) { return __builtin_bit_cast(float, w << 16); }
__device__ __forceinline__ float bfhi(unsigned w) { return __builtin_bit_cast(float, w & 0xffff0000u); }
__device__ __forceinline__ float sigmoidf_(float x) { return __builtin_amdgcn_rcpf(1.0f + __expf(-x)); }
__device__ __forceinline__ unsigned q8x4(f32x4 v) { return (unsigned)(v[0] * 255.0f + 0.5f) | ((unsigned)(v[1] * 255.0f + 0.5f) << 8) | ((unsigned)(v[2] * 255.0f + 0.5f) << 16) | ((unsigned)(v[3] * 255.0f + 0.5f) << 24); }
__device__ __forceinline__ void u8x8(u32x2 w, float (&f)[8]) { f[0] = (float)(w.x & 0xffu); f[1] = (float)((w.x >> 8) & 0xffu); f[2] = (float)((w.x >> 16) & 0xffu); f[3] = (float)(w.x >> 24); f[4] = (float)(w.y & 0xffu); f[5] = (float)((w.y >> 8) & 0xffu); f[6] = (float)((w.y >> 16) & 0xffu); f[7] = (float)(w.y >> 24); }

namespace pg8 {
#define PG8_LAS __attribute__((address_space(3)))
constexpr int BM = 256, BK = 64, HALF = 128, HTB = HALF * BK * 2  , STAGE_BYTES = 8 * HTB, NXCD = 8, WGM = 8;

__host__ __device__ __forceinline__ int lds_byte(int r, int c) { const int st = (r >> 4) * 2 + (c >> 5), rr = r & 15, cc = c & 31, ob = rr * 64 + cc * 2; return st * 1024 + (ob ^ (((ob >> 9) & 1) << 5)); }
__host__ __device__ __forceinline__ void stage_rc(int b, int& R, int& C) { const int st = b / 1024, sb = b % 1024, swz = sb ^ (((sb >> 9) & 1) << 5); R = (st >> 1) * 16 + swz / 64; C = (st & 1) * 32 + (swz % 64) / 2; }
__host__ __device__ __forceinline__ int perm32(int rho) { const int n = rho >> 4, i = rho & 15; return 8 * (i >> 2) + 4 * n + (i & 3); }

struct Unit { int pm, pn, kt0, nt, sp; };
struct Gemm { const bf16_t* A; const bf16_t* Bt; int M, N, K; };

struct StaticOrder {
    int nM, nN, nwg, G, c;
    __host__ __device__ void init(int M_, int N_, int G_, int c_) { nM = M_ / BM; nN = N_ / BM; nwg = nM * nN; G = G_; c = c_; }
    __host__ __device__ bool next(int i, Unit& u) const {
        const long L = (long)i * G + c; if (L >= nwg) return false;
        int wgid = (int)L; { const int q = nwg / NXCD, r = nwg % NXCD, xcd = wgid % NXCD, off = wgid / NXCD; wgid = (xcd < r ? xcd * (q + 1) : r * (q + 1) + (xcd - r) * q) + off; }
        const int nig = WGM * nN, gid = wgid / nig, fm = gid * WGM, gsz = (nM - fm) < WGM ? (nM - fm) : WGM;
        u.pm = fm + ((wgid % nig) % gsz); u.pn = (wgid % nig) / gsz; return true;
    }
    __device__ __forceinline__ void a_ready(const Unit&) const {}
    __device__ __forceinline__ void done(const Unit&) const {}
};
struct PhaseOrder {
    int nNp, nwg, nN, S, ntf, c, G; bool lin;
    __device__ __forceinline__ void init(int N_, int K_, int S_, int G_, int c_) { nN = N_ / BM; nNp = nN; nwg = (MP / BM) * nN; S = S_; ntf = K_ / BK; c = c_; G = G_; lin = false; }
    __device__ __forceinline__ bool next(int i, Unit& u) const {
        if (lin) { const int Ll = (c < 64) ? (i == 0 ? c : 1 << 20) : c + 192 * i; u.pm = Ll >> 3; u.pn = Ll & 7; u.sp = -1; u.nt = ntf; u.kt0 = 0; return Ll < (M / BM) * 8; }
        const int L = i * G + c; const bool isP = L < nwg;
        int wgid = isP ? L : 0; { const int q = nwg / NXCD, r = nwg % NXCD, xcd = wgid % NXCD, off = wgid / NXCD; wgid = (xcd < r ? xcd * (q + 1) : r * (q + 1) + (xcd - r) * q) + off; }
        const int nig = WGM * nN, gid = wgid / nig, fm = gid * WGM;
        const int pm = fm + ((wgid % nig) % WGM), pn = (wgid % nig) / WGM;
        const int np = (nwg - c + G - 1) / G;
        const int x = c & 7, ii = c >> 3, j = G - 1 - c; const bool split = S > 1;
        const bool s8 = (S == 8);
        const bool okS = (i == np) && (split ? (s8 ? ii < nN : ii < nN / 2) : (j < nN));
        const int snt = split ? ntf / S : ntf;
        u.pm = isP ? pm : MP / BM; u.pn = isP ? pn : (split ? (s8 ? ii : (nN / 2) * (x >> 2) + ii) : j);
        const int spx = s8 ? x : (x & 3);
        u.sp = (isP || !split) ? -1 : spx; u.nt = isP ? ntf : snt; u.kt0 = (isP || !split) ? 0 : spx * snt;
        return isP || okS;
    }
    __device__ __forceinline__ void a_ready(const Unit&) const {}
    __device__ __forceinline__ void done(const Unit&) const {}
};

enum { MODE_GU = 0, MODE_RES = 1, MODE_IN = 2, MODE_MG2 = 3, MODE_F32 = 5, MODE_OUT = 6 };
struct Epi {
    static constexpr bool PERM = true, AFTER_DRAIN = false;
    int mode; float scale; int step, S, mypm;
    const PG8_LAS float* rtab;
    unsigned char* ws; float* dout;
    unsigned ssp_in_off, ssp_out_off;
    const float* xp; const float* xs;
    const float* qn; const float* kn;

    __device__ __forceinline__ void operator()(f32x4 (&acc)[2][2][4][2], const Unit& u, int wr, int wc, int fr, int fq) const {
        asm volatile("" : "+v"(fr), "+v"(fq));
        const float* ssp_in = ssp_in_off ? (const float*)(ws + ssp_in_off) : nullptr; float* ssp_out = (float*)(ws + ssp_out_off);
        bf16_t* o16 = (bf16_t*)(ws + (mode == MODE_GU ? WS_A1 : WS_HB)); unsigned* cnt = (unsigned*)(ws + WS_CTL) + CW_SPLIT + step * 512;
        int qsel = -1;
        if (u.sp >= 0) {
            typedef unsigned long long u64;
            const int wv = wr * 4 + wc, lane = fq * 16 + fr;
            f32x4* part = (f32x4*)(ws + WS_PART) + ((size_t)(u.pn * S) * 8 + wv) * 2048 + lane;
#pragma unroll
            for (int ai = 0; ai < 2; ++ai)
#pragma unroll
                for (int bj = 0; bj < 2; ++bj)
#pragma unroll
                    for (int m = 0; m < 4; ++m)
#pragma unroll
                        for (int n = 0; n < 2; ++n) {
                            u64* q = (u64*)(part + (size_t)u.sp * 8 * 2048 + (((ai * 2 + bj) * 4 + m) * 2 + n) * 64); const f32x4 v = acc[ai][bj][m][n];
                            __hip_atomic_store(q, ((u64)__float_as_uint(v[1]) << 32) | __float_as_uint(v[0]), __ATOMIC_RELAXED, __HIP_MEMORY_SCOPE_AGENT);
                            __hip_atomic_store(q + 1, ((u64)__float_as_uint(v[3]) << 32) | __float_as_uint(v[2]), __ATOMIC_RELAXED, __HIP_MEMORY_SCOPE_AGENT);
                        }
            asm volatile("s_waitcnt vmcnt(0)" ::: "memory");
            unsigned* cw = cnt + u.pn * 8 + wv;
            if (lane == 0) __hip_atomic_fetch_add(cw, 1u, __ATOMIC_RELAXED, __HIP_MEMORY_SCOPE_AGENT);
            { unsigned spins = 0; while ((unsigned)__builtin_amdgcn_readfirstlane((int)__hip_atomic_load(cw, __ATOMIC_RELAXED, __HIP_MEMORY_SCOPE_AGENT)) < (unsigned)S) { __builtin_amdgcn_s_sleep(2); if (++spins > (1u << 22)) break; } }
            __builtin_amdgcn_fence(__ATOMIC_ACQUIRE, "agent"); asm volatile("s_waitcnt vmcnt(0)" ::: "memory");
            qsel = u.sp;
            if (S == 8) {
                const int qa = qsel >> 2, qm = qsel & 3;
                f32x4 h[2][2][2];
#pragma unroll
                for (int hf = 0; hf < 2; ++hf) {
                    f32x4 t[4][2][2];
#pragma unroll
                    for (int s = 0; s < 4; ++s)
#pragma unroll
                        for (int bj = 0; bj < 2; ++bj)
#pragma unroll
                            for (int n = 0; n < 2; ++n) t[s][bj][n] = part[(size_t)(4 * hf + s) * 8 * 2048 + (((qa * 2 + bj) * 4 + qm) * 2 + n) * 64];
#pragma unroll
                    for (int bj = 0; bj < 2; ++bj)
#pragma unroll
                        for (int n = 0; n < 2; ++n) h[hf][bj][n] = (t[0][bj][n] + t[1][bj][n]) + (t[2][bj][n] + t[3][bj][n]);
                }
#pragma unroll
                for (int bj = 0; bj < 2; ++bj)
#pragma unroll
                    for (int n = 0; n < 2; ++n) { acc[1][bj][0][n] = h[1][bj][n]; acc[0][bj][0][n] = (mode == MODE_MG2) ? h[0][bj][n] : h[0][bj][n] + h[1][bj][n]; }
            } else {
                const int qa = qsel >> 1, qm = (qsel & 1) * 2;
#pragma unroll
                for (int mm = 0; mm < 2; ++mm) {
                    f32x4 t[4][2][2];
#pragma unroll
                    for (int s = 0; s < 4; ++s)
#pragma unroll
                        for (int bj = 0; bj < 2; ++bj)
#pragma unroll
                            for (int n = 0; n < 2; ++n) t[s][bj][n] = part[(size_t)s * 8 * 2048 + (((qa * 2 + bj) * 4 + qm + mm) * 2 + n) * 64];
#pragma unroll
                    for (int bj = 0; bj < 2; ++bj)
#pragma unroll
                        for (int n = 0; n < 2; ++n) {
                            const f32x4 s01 = t[0][bj][n] + t[1][bj][n], s23 = t[2][bj][n] + t[3][bj][n];
                            acc[1][bj][mm][n] = s23;
                            acc[0][bj][mm][n] = (mode == MODE_MG2) ? s01 : s01 + s23;
                        }
                }
            }
        }
        const int mlim = (S == 8) ? 1 : 2;
#define QSKIP(ai, m) if (qsel >= 0 && ((ai) != 0 || (m) >= mlim)) continue
        const int row0 = u.pm * BM + wr * 64 + fr + (qsel < 0 ? 0 : (S == 8 ? (qsel >> 2) * HALF + (qsel & 3) * 16 : (qsel >> 1) * HALF + (qsel & 1) * 32));
        const int cl = wc * 32 + 8 * fq;
        auto rsf = [&](int row) -> float {
            if (!ssp_in) return 1.0f;
            if (u.pm == mypm) return rtab[row & (BM - 1)];
            const float* p = ssp_in + (size_t)(8 * fq) * M + row;
            float s = ((p[0] + p[(size_t)M]) + (p[2 * (size_t)M] + p[3 * (size_t)M])) + ((p[4 * (size_t)M] + p[5 * (size_t)M]) + (p[6 * (size_t)M] + p[7 * (size_t)M]));
            s += __shfl_xor(s, 16); s += __shfl_xor(s, 32);
            return rsqrtf(s * (1.0f / D) + EPS);
        };
        if (mode == MODE_GU) {
#pragma unroll
            for (int ai = 0; ai < 2; ++ai)
#pragma unroll
                for (int m = 0; m < 4; ++m) {
                    QSKIP(ai, m);
                    const int row = row0 + ai * HALF + m * 16; const float r = rsf(row);
                    float o[8];
#pragma unroll
                    for (int n = 0; n < 2; ++n)
#pragma unroll
                        for (int j = 0; j < 4; ++j) { const float g = acc[ai][0][m][n][j] * r, uu = acc[ai][1][m][n][j] * r; o[4 * n + j] = g * sigmoidf_(g) * uu; }
                    u32x4 w; w.x = pk2(o[0], o[1]); w.y = pk2(o[2], o[3]); w.z = pk2(o[4], o[5]); w.w = pk2(o[6], o[7]);
                    *(u32x4*)(o16 + (size_t)row * FF + u.pn * HALF + cl) = w;
                }
        } else if (mode == MODE_RES) {
            const bf16_t* xb = xp ? (const bf16_t*)(ws + WS_XN) : o16;
            const float* rms0 = (const float*)(ws + WS_RMS0);
#pragma unroll
            for (int ai = 0; ai < 2; ++ai) {
                if (qsel >= 0 && ai != 0) continue;
                f32x4 bb[4][2][2];
#pragma unroll
                for (int m = 0; m < 4; ++m) {
                    if (qsel >= 0 && m >= mlim) continue;
                    const size_t off = (size_t)(row0 + ai * HALF + m * 16) * D + u.pn * BM + cl;
#pragma unroll
                    for (int bj = 0; bj < 2; ++bj) {
                        const u32x4 hb = *(const u32x4*)(xb + off + bj * HALF); bb[m][bj][0] = (f32x4){bflo(hb.x), bfhi(hb.x), bflo(hb.y), bfhi(hb.y)}; bb[m][bj][1] = (f32x4){bflo(hb.z), bfhi(hb.z), bflo(hb.w), bfhi(hb.w)};
                    }
                }
#pragma unroll
                for (int m = 0; m < 4; ++m) {
                    QSKIP(ai, m);
                    const int row = row0 + ai * HALF + m * 16; const size_t off = (size_t)row * D + u.pn * BM + cl; float ss = 0.f;
                    const float bs = xp ? (u.pm == mypm ? rtab[BM + (row & (BM - 1))] : rms0[row]) : 1.0f;
#pragma unroll
                    for (int bj = 0; bj < 2; ++bj) {
                        const f32x4 v0 = bb[m][bj][0] * bs + acc[ai][bj][m][0] * scale, v1 = bb[m][bj][1] * bs + acc[ai][bj][m][1] * scale;
                        u32x4 w; w.x = pk2(v0[0], v0[1]); w.y = pk2(v0[2], v0[3]); w.z = pk2(v1[0], v1[1]); w.w = pk2(v1[2], v1[3]);
                        *(u32x4*)(o16 + off + bj * HALF) = w;
                        ss += (v0[0] * v0[0] + v0[1] * v0[1]) + (v0[2] * v0[2] + v0[3] * v0[3]) + (v1[0] * v1[0] + v1[1] * v1[1]) + (v1[2] * v1[2] + v1[3] * v1[3]);
                    }
                    ss += __shfl_xor(ss, 16); ss += __shfl_xor(ss, 32);
                    if (fq == 0) ssp_out[(size_t)(u.pn * 4 + wc) * M + row] = ss;
                }
            }
        } else if (mode == MODE_IN) {
            const int pn = u.pn;
            if (pn >= 4 && pn < 12) {
                bf16_t* U = (bf16_t*)(ws + WS_U);
#pragma unroll
                for (int ai = 0; ai < 2; ++ai)
#pragma unroll
                    for (int m = 0; m < 4; ++m) {
                    QSKIP(ai, m);
                        const int row = row0 + ai * HALF + m * 16; const float r_ = rsf(row), r2 = r_ * r_; const int col = (pn - 4) * HALF + cl;
                        const f32x4 v0 = acc[ai][0][m][0] * acc[ai][1][m][0] * r2, v1 = acc[ai][0][m][1] * acc[ai][1][m][1] * r2;
                        u32x4 w; w.x = pk2(v0[0], v0[1]); w.y = pk2(v0[2], v0[3]); w.z = pk2(v1[0], v1[1]); w.w = pk2(v1[2], v1[3]);
                        *(u32x4*)(U + (size_t)row * DC + col) = w;
                        float* cs = nullptr;
                        if (row < MP) { const int t = row & (SEQ - 1); if (t >= SEQ - 2) cs = dout + O_CONVP + ((size_t)(row >> 13) * 2 + (t - (SEQ - 2))) * DC + col; }
                        else { const int t = row & 15; if (t >= 14) cs = dout + O_CONVS + ((size_t)((row - MP) >> 4) * 2 + (t - 14)) * DC + col; }
                        if (cs) { *(f32x4*)cs = v0; *(f32x4*)(cs + 4) = v1; }
                    }
            } else if (pn >= 12 && pn < 17) {
                const bool isk = (pn == 16); const float* gn = isk ? kn : qn;
                f32x4 gv[2][2];
#pragma unroll
                for (int bj = 0; bj < 2; ++bj) { gv[bj][0] = *(const f32x4*)(gn + 32 * bj + 8 * fq); gv[bj][1] = *(const f32x4*)(gn + 32 * bj + 8 * fq + 4); }
                bf16_t* O = isk ? (bf16_t*)(ws + WS_K) : (bf16_t*)(ws + WS_Q); const int ldo = isk ? 256 : 1024; const int hcol = (isk ? wc : 4 * (pn - 12) + wc) * 64 + 8 * fq;
#pragma unroll
                for (int ai = 0; ai < 2; ++ai)
#pragma unroll
                    for (int m = 0; m < 4; ++m) {
                    QSKIP(ai, m);
                        const int row = row0 + ai * HALF + m * 16; const float r = rsf(row);
                        f32x4 v[2][2]; float ss = 0.f;
#pragma unroll
                        for (int bj = 0; bj < 2; ++bj)
#pragma unroll
                            for (int n = 0; n < 2; ++n) { v[bj][n] = acc[ai][bj][m][n] * r; ss += (v[bj][n][0] * v[bj][n][0] + v[bj][n][1] * v[bj][n][1]) + (v[bj][n][2] * v[bj][n][2] + v[bj][n][3] * v[bj][n][3]); }
                        ss += __shfl_xor(ss, 16); ss += __shfl_xor(ss, 32);
                        const float hr = rsqrtf(ss * (1.0f / 64.0f) + EPS);
                        float* fo = nullptr;
                        if (isk) { if (row >= MP) fo = dout + O_KS + (size_t)(row - MP) * 256 + wc * 64 + 8 * fq;
                                   else { const int t = row & (SEQ - 1); if (t >= SEQ - 128) fo = dout + O_KP + ((size_t)(row >> 13) * 128 + (t - (SEQ - 128))) * 256 + wc * 64 + 8 * fq; } }
#pragma unroll
                        for (int bj = 0; bj < 2; ++bj) {
                            const f32x4 o0 = v[bj][0] * hr * gv[bj][0], o1 = v[bj][1] * hr * gv[bj][1];
                            u32x4 w; w.x = pk2(o0[0], o0[1]); w.y = pk2(o0[2], o0[3]); w.z = pk2(o1[0], o1[1]); w.w = pk2(o1[2], o1[3]);
                            *(u32x4*)(O + (size_t)row * ldo + hcol + 32 * bj) = w;
                            if (fo) { *(f32x4*)(fo + 32 * bj) = o0; *(f32x4*)(fo + 32 * bj + 4) = o1; }
                        }
                    }
            } else {
                bf16_t* O; int ldo, colt; bool sg = false, isv = false;
                if (pn < 4) { O = (bf16_t*)(ws + WS_CB); ldo = DC; colt = pn * BM; }
                else if (pn == 17) { O = (bf16_t*)(ws + WS_V); ldo = 256; colt = 0; isv = true; }
                else if (pn < 26) { O = (bf16_t*)(ws + WS_SGC); ldo = D; colt = (pn - 18) * BM; sg = true; }
                else { O = (bf16_t*)(ws + WS_SGA); ldo = D; colt = (pn - 26) * BM; sg = true; }
#pragma unroll
                for (int ai = 0; ai < 2; ++ai)
#pragma unroll
                    for (int m = 0; m < 4; ++m) {
                    QSKIP(ai, m);
                        const int row = row0 + ai * HALF + m * 16; const float r = rsf(row);
                        float* fo = nullptr;
                        if (isv) { if (row >= MP) fo = dout + O_VS + (size_t)(row - MP) * 256 + cl;
                                   else { const int t = row & (SEQ - 1); if (t >= SEQ - 128) fo = dout + O_VP + ((size_t)(row >> 13) * 128 + (t - (SEQ - 128))) * 256 + cl; } }
#pragma unroll
                        for (int bj = 0; bj < 2; ++bj) {
                            f32x4 v0 = acc[ai][bj][m][0] * r, v1 = acc[ai][bj][m][1] * r;
                            if (sg) {
#pragma unroll
                                for (int j = 0; j < 4; ++j) { v0[j] = sigmoidf_(v0[j]); v1[j] = sigmoidf_(v1[j]); } }
                            if (sg) { u32x2 q; q.x = q8x4(v0); q.y = q8x4(v1); *(u32x2*)((unsigned char*)O + (size_t)row * D + colt + bj * HALF + cl) = q; }
                            else { u32x4 w; w.x = pk2(v0[0], v0[1]); w.y = pk2(v0[2], v0[3]); w.z = pk2(v1[0], v1[1]); w.w = pk2(v1[2], v1[3]);
                                *(u32x4*)(O + (size_t)row * ldo + colt + bj * HALF + cl) = w; }
                            if (fo) { *(f32x4*)(fo + bj * HALF) = v0; *(f32x4*)(fo + bj * HALF + 4) = v1; }
                        }
                    }
            }
        } else if (mode == MODE_MG2) {
            const unsigned char* SGC = (const unsigned char*)(ws + WS_SGC); const unsigned char* SGA = (const unsigned char*)(ws + WS_SGA); bf16_t* MG = (bf16_t*)(ws + WS_MG);
#pragma unroll
            for (int ai = 0; ai < 2; ++ai) {
                if (qsel >= 0 && ai != 0) continue;
                u32x2 sa[4][2], sc[4][2];
#pragma unroll
                for (int m = 0; m < 4; ++m) {
                    if (qsel >= 0 && m >= mlim) continue;
#pragma unroll
                    for (int bj = 0; bj < 2; ++bj) { const size_t off = (size_t)(row0 + ai * HALF + m * 16) * D + u.pn * BM + bj * HALF + cl; sa[m][bj] = *(const u32x2*)(SGA + off); if (qsel >= 0) sc[m][bj] = *(const u32x2*)(SGC + off); }
                }
#pragma unroll
                for (int m = 0; m < 4; ++m) {
                    QSKIP(ai, m);
                    const int row = row0 + ai * HALF + m * 16;
#pragma unroll
                    for (int bj = 0; bj < 2; ++bj) {
                        const size_t off = (size_t)row * D + u.pn * BM + bj * HALF + cl;
                        float ga[8]; u8x8(sa[m][bj], ga);
                        const f32x4 a0 = acc[ai][bj][m][0], a1 = acc[ai][bj][m][1];
                        float o[8];
                        if (qsel >= 0) {
                            float gc[8]; u8x8(sc[m][bj], gc); const f32x4 b0 = acc[1][bj][m][0], b1 = acc[1][bj][m][1];
#pragma unroll
                            for (int j = 0; j < 4; ++j) { o[j] = (a0[j] * gc[j] + b0[j] * ga[j]) * (1.0f / 255.0f); o[4 + j] = (a1[j] * gc[4 + j] + b1[j] * ga[4 + j]) * (1.0f / 255.0f); }
                        } else {
#pragma unroll
                            for (int j = 0; j < 4; ++j) { o[j] = a0[j] * (fmaxf(ga[j], 0.5f) * (1.0f / 255.0f)); o[4 + j] = a1[j] * (fmaxf(ga[4 + j], 0.5f) * (1.0f / 255.0f)); }
                        }
                        u32x4 w; w.x = pk2(o[0], o[1]); w.y = pk2(o[2], o[3]); w.z = pk2(o[4], o[5]); w.w = pk2(o[6], o[7]);
                        *(u32x4*)(MG + off) = w;
                    }
                }
            }
        } else {
            bf16_t* T = (bf16_t*)(ws + WS_T); const bf16_t* HBp = (const bf16_t*)(ws + WS_HB); const bool fin = (mode == MODE_OUT);
#pragma unroll
            for (int ai = 0; ai < 2; ++ai) {
                if (qsel >= 0 && ai != 0) continue;
                u32x4 tt[4][2], hh[4][2];
                if (fin) {
#pragma unroll
                    for (int m = 0; m < 4; ++m) {
                        if (qsel >= 0 && m >= mlim) continue;
#pragma unroll
                        for (int bj = 0; bj < 2; ++bj) { const size_t off = (size_t)(row0 + ai * HALF + m * 16) * D + u.pn * BM + bj * HALF + cl; tt[m][bj] = *(const u32x4*)(T + off); hh[m][bj] = *(const u32x4*)(HBp + off); }
                    }
                }
#pragma unroll
                for (int m = 0; m < 4; ++m) {
                    QSKIP(ai, m);
                    const int row = row0 + ai * HALF + m * 16; const float r = rsf(row);
#pragma unroll
                    for (int bj = 0; bj < 2; ++bj) {
                        const size_t off = (size_t)row * D + u.pn * BM + bj * HALF + cl;
                        f32x4 v0 = acc[ai][bj][m][0], v1 = acc[ai][bj][m][1];
                        if (fin) {
                            const u32x4 t = tt[m][bj], hb = hh[m][bj]; const f32x4 h0 = {bflo(hb.x), bfhi(hb.x), bflo(hb.y), bfhi(hb.y)}, h1 = {bflo(hb.z), bfhi(hb.z), bflo(hb.w), bfhi(hb.w)};
                            const f32x4 t0 = {bflo(t.x), bfhi(t.x), bflo(t.y), bfhi(t.y)}, t1 = {bflo(t.z), bfhi(t.z), bflo(t.w), bfhi(t.w)};
#pragma unroll
                            for (int j = 0; j < 4; ++j) { v0[j] = h0[j] + t0[j] * sigmoidf_(v0[j] * r); v1[j] = h1[j] + t1[j] * sigmoidf_(v1[j] * r); }
                            *(f32x4*)(dout + off) = v0; *(f32x4*)(dout + off + 4) = v1;
                        } else { u32x4 w; w.x = pk2(v0[0], v0[1]); w.y = pk2(v0[2], v0[3]); w.z = pk2(v1[0], v1[1]); w.w = pk2(v1[2], v1[3]); *(u32x4*)(T + off) = w; }
                    }
                }
            }
        }
    }
#undef QSKIP
    __device__ __forceinline__ void mid(f32x4 (&acc)[2][2][4][2], const Unit& u, int wr, int wc, int fr, int fq) const {
        asm volatile("" : "+v"(fr), "+v"(fq));
        const unsigned char* SGC = (const unsigned char*)(ws + WS_SGC); const unsigned char* SGA = (const unsigned char*)(ws + WS_SGA);
        const int row0 = u.pm * BM + wr * 64 + fr, cl = wc * 32 + 8 * fq;
        u32x2 cc[2][4][2], ss[2][4][2];
#pragma unroll
        for (int ai = 0; ai < 2; ++ai)
#pragma unroll
            for (int m = 0; m < 4; ++m)
#pragma unroll
                for (int bj = 0; bj < 2; ++bj) { const size_t off = (size_t)(row0 + ai * HALF + m * 16) * D + u.pn * BM + bj * HALF + cl; cc[ai][m][bj] = *(const u32x2*)(SGC + off); ss[ai][m][bj] = *(const u32x2*)(SGA + off); }
#pragma unroll
        for (int ai = 0; ai < 2; ++ai)
#pragma unroll
            for (int m = 0; m < 4; ++m)
#pragma unroll
                for (int bj = 0; bj < 2; ++bj) {
                    float gc[8], ga[8]; u8x8(cc[ai][m][bj], gc); u8x8(ss[ai][m][bj], ga);
#pragma unroll
                    for (int j = 0; j < 4; ++j) { acc[ai][bj][m][0][j] *= gc[j] * __builtin_amdgcn_rcpf(fmaxf(ga[j], 0.5f)); acc[ai][bj][m][1][j] *= gc[4 + j] * __builtin_amdgcn_rcpf(fmaxf(ga[4 + j], 0.5f)); }
                }
    }
};

template <class Epi, class Sched, bool ALIGN_EPI = false, bool SP2 = false>
__device__ __forceinline__ void gemm_phase(PG8_LAS unsigned char* lds, const Gemm g, const Sched& S, const Epi& E) {
    const int tid = threadIdx.x, wid = __builtin_amdgcn_readfirstlane(tid >> 6), lane = tid & 63, wr = wid >> 2, wc = wid & 3, fr = lane & 15, fq = lane >> 4;
    const int K = g.K;
    unsigned voffA[2], voffB[2];
#pragma unroll
    for (int i = 0; i < 2; ++i) { int R, C; stage_rc(tid * 16 + i * 8192, R, C); const int Rb = Epi::PERM ? ((R & ~31) + perm32(R & 31)) : R;
        voffA[i] = (unsigned)(R * K + C) * 2u; voffB[i] = (unsigned)(Rb * K + C) * 2u; }
    const size_t kstep = (size_t)(BK * 2);
    const size_t hstep = (size_t)HALF * K * 2;
    const size_t tstep = 2 * hstep;
    const unsigned ldsw = (unsigned)wid * 1024u;
    const int aoff = lds_byte(wr * 64 + fr, fq * 8), boff = lds_byte(wc * 32 + fr, fq * 8);
#define PG8_SA(b, h) (((b) * 2 + (h)) * HTB)
#define PG8_SB(b, h) ((4 + (b) * 2 + (h)) * HTB)
#define PG8_STAGE(bufoff, gbase, voff) do { _Pragma("unroll") for (int _i = 0; _i < 2; ++_i) \
        __builtin_amdgcn_global_load_lds((const unsigned*)((const char*)(gbase) + (voff)[_i]), (PG8_LAS unsigned*)(lds + (bufoff) + ldsw + _i * 8192), 16, 0, 0); } while (0)
#define PG8_LDA(dst, b, h) do { _Pragma("unroll") for (int m = 0; m < 4; ++m) _Pragma("unroll") for (int k = 0; k < 2; ++k) dst[m][k] = *(const PG8_LAS bf16x8*)(lds + PG8_SA(b, h) + aoff + m * 2048 + k * 1024); } while (0)
#define PG8_LDB(dst, b, h) do { _Pragma("unroll") for (int n = 0; n < 2; ++n) _Pragma("unroll") for (int k = 0; k < 2; ++k) dst[n][k] = *(const PG8_LAS bf16x8*)(lds + PG8_SB(b, h) + boff + n * 2048 + k * 1024); } while (0)
#define PG8_MMA(ai, bj, At, Bt) do { __builtin_amdgcn_s_setprio(1); _Pragma("unroll") for (int m = 0; m < 4; ++m) _Pragma("unroll") for (int n = 0; n < 2; ++n) _Pragma("unroll") for (int k = 0; k < 2; ++k) \
        acc[ai][bj][m][n] = __builtin_amdgcn_mfma_f32_16x16x32_bf16(Bt[n][k], At[m][k], acc[ai][bj][m][n], 0, 0, 0); __builtin_amdgcn_s_setprio(0); } while (0)
#define PG8_WAIT_V(n) asm volatile("s_waitcnt vmcnt(" #n ")" ::: "memory")
#define PG8_WAIT_L(n) asm volatile("s_waitcnt lgkmcnt(" #n ")" ::: "memory")
#define PG8_BAR __builtin_amdgcn_s_barrier()
#define PG8_SCHED __builtin_amdgcn_sched_barrier(0)
    Unit cur, nxt; int ui = 0;
    if (!S.next(0, cur)) return;
    f32x4 acc[2][2][4][2];
#pragma unroll
    for (int a = 0; a < 2; ++a)
#pragma unroll
        for (int b = 0; b < 2; ++b)
#pragma unroll
            for (int m = 0; m < 4; ++m)
#pragma unroll
                for (int n = 0; n < 2; ++n) acc[a][b][m][n] = (f32x4){0.f, 0.f, 0.f, 0.f};
    bf16x8 At[4][2], B0[2][2], B1[2][2];
    const char* cA = (const char*)g.A + (size_t)cur.pm * tstep + (size_t)cur.kt0 * kstep; const char* cB = (const char*)g.Bt + (size_t)cur.pn * tstep + (size_t)cur.kt0 * kstep;
    S.a_ready(cur);
    if constexpr (SP2) {
        PG8_STAGE(PG8_SB(0, 0), cB, voffB); PG8_STAGE(PG8_SB(0, 1), cB + hstep, voffB); PG8_STAGE(PG8_SA(0, 0), cA, voffA); PG8_STAGE(PG8_SA(0, 1), cA + hstep, voffA);
        if (wr == 1) PG8_BAR;
        PG8_WAIT_V(2); PG8_BAR;
        PG8_STAGE(PG8_SB(1, 0), cB + kstep, voffB); PG8_STAGE(PG8_SA(1, 0), cA + kstep, voffA); PG8_STAGE(PG8_SB(1, 1), cB + hstep + kstep, voffB);
        PG8_WAIT_V(6); PG8_BAR;
    } else {
        PG8_STAGE(PG8_SB(0, 0), cB, voffB); PG8_STAGE(PG8_SA(0, 0), cA, voffA); PG8_STAGE(PG8_SB(0, 1), cB + hstep, voffB); PG8_STAGE(PG8_SA(0, 1), cA + hstep, voffA);
        if (wr == 1) PG8_BAR;
        PG8_WAIT_V(4); PG8_BAR;
        PG8_STAGE(PG8_SB(1, 0), cB + kstep, voffB); PG8_STAGE(PG8_SA(1, 0), cA + kstep, voffA); PG8_STAGE(PG8_SB(1, 1), cB + hstep + kstep, voffB);
        PG8_WAIT_V(6); PG8_BAR;
    }
    for (;;) {
        const bool has_next = S.next(ui + 1, nxt);
        const char* nA = has_next ? (const char*)g.A + (size_t)nxt.pm * tstep + (size_t)nxt.kt0 * kstep : cA; const char* nB = has_next ? (const char*)g.Bt + (size_t)nxt.pn * tstep + (size_t)nxt.kt0 * kstep : cB;
        const int nt = cur.nt;
        for (int t = 0; t < nt; t += 2) {
            const bool last = (t == nt - 2);
            const char* a1 = cA + (size_t)(t + 1) * kstep;
            const char* a2 = last ? nA : cA + (size_t)(t + 2) * kstep; const char* b2 = last ? nB : cB + (size_t)(t + 2) * kstep;
            const char* a3 = a2 + kstep; const char* b3 = b2 + kstep;
            if (last && has_next) S.a_ready(nxt);
            if (E.mode == MODE_MG2 && cur.sp < 0 && t == (nt >> 1)) E.mid(acc, cur, wr, wc, fr, fq);
            if constexpr (SP2) {
            PG8_LDB(B0, 0, 0); PG8_LDB(B1, 0, 1); PG8_SCHED; PG8_LDA(At, 0, 0); PG8_STAGE(PG8_SA(1, 1), a1 + hstep, voffA);
            PG8_WAIT_V(8); PG8_WAIT_L(0); PG8_BAR; PG8_MMA(0, 0, At, B0); PG8_MMA(0, 1, At, B1); PG8_BAR; PG8_SCHED;
            PG8_LDA(At, 0, 1); PG8_STAGE(PG8_SB(0, 0), b2, voffB); PG8_STAGE(PG8_SB(0, 1), b2 + hstep, voffB); PG8_STAGE(PG8_SA(0, 0), a2, voffA);
            PG8_WAIT_V(8); PG8_WAIT_L(0); PG8_BAR; PG8_MMA(1, 0, At, B0); PG8_MMA(1, 1, At, B1); PG8_BAR; PG8_SCHED;
            PG8_LDB(B0, 1, 0); PG8_LDB(B1, 1, 1); PG8_SCHED; PG8_LDA(At, 1, 0); PG8_STAGE(PG8_SA(0, 1), a2 + hstep, voffA);
            PG8_WAIT_V(8); PG8_WAIT_L(0); PG8_BAR; PG8_MMA(0, 0, At, B0); PG8_MMA(0, 1, At, B1); PG8_BAR; PG8_SCHED;
            PG8_LDA(At, 1, 1); PG8_STAGE(PG8_SB(1, 0), b3, voffB); PG8_STAGE(PG8_SB(1, 1), b3 + hstep, voffB); PG8_STAGE(PG8_SA(1, 0), a3, voffA);
            PG8_WAIT_V(8); PG8_WAIT_L(0); PG8_BAR; PG8_MMA(1, 0, At, B0); PG8_MMA(1, 1, At, B1); PG8_BAR; PG8_SCHED;
            } else {
            PG8_LDB(B0, 0, 0); PG8_SCHED; PG8_LDA(At, 0, 0); PG8_STAGE(PG8_SA(1, 1), a1 + hstep, voffA);
            PG8_WAIT_L(8); PG8_BAR; PG8_WAIT_L(0); PG8_MMA(0, 0, At, B0); PG8_BAR; PG8_SCHED;
            PG8_LDB(B1, 0, 1); PG8_STAGE(PG8_SB(0, 0), b2, voffB);
            PG8_BAR; PG8_WAIT_L(0); PG8_MMA(0, 1, At, B1); PG8_BAR;
            PG8_LDA(At, 0, 1); PG8_STAGE(PG8_SA(0, 0), a2, voffA);
            PG8_BAR; PG8_WAIT_L(0); PG8_MMA(1, 0, At, B0); PG8_BAR; PG8_SCHED;
            PG8_STAGE(PG8_SB(0, 1), b2 + hstep, voffB);
            PG8_WAIT_V(6); PG8_BAR; PG8_MMA(1, 1, At, B1); PG8_BAR;
            PG8_LDB(B0, 1, 0); PG8_SCHED; PG8_LDA(At, 1, 0); PG8_STAGE(PG8_SA(0, 1), a2 + hstep, voffA);
            PG8_WAIT_L(8); PG8_BAR; PG8_WAIT_L(0); PG8_MMA(0, 0, At, B0); PG8_BAR; PG8_SCHED;
            PG8_LDB(B1, 1, 1); PG8_STAGE(PG8_SB(1, 0), b3, voffB);
            PG8_BAR; PG8_WAIT_L(0); PG8_MMA(0, 1, At, B1); PG8_BAR;
            PG8_LDA(At, 1, 1); PG8_STAGE(PG8_SA(1, 0), a3, voffA);
            PG8_BAR; PG8_WAIT_L(0); PG8_MMA(1, 0, At, B0); PG8_BAR; PG8_SCHED;
            PG8_STAGE(PG8_SB(1, 1), b3 + hstep, voffB);
            PG8_WAIT_V(6); PG8_BAR; PG8_MMA(1, 1, At, B1); PG8_BAR;
            }
        }
        if constexpr (ALIGN_EPI) { if (wr == 0) PG8_BAR; }
        if constexpr (!Epi::AFTER_DRAIN) { E(acc, cur, wr, wc, fr, fq); S.done(cur); }
        if (!has_next) break;
#pragma unroll
        for (int a = 0; a < 2; ++a)
#pragma unroll
            for (int b = 0; b < 2; ++b)
#pragma unroll
                for (int m = 0; m < 4; ++m)
#pragma unroll
                    for (int n = 0; n < 2; ++n) acc[a][b][m][n] = (f32x4){0.f, 0.f, 0.f, 0.f};
        cur = nxt; cA = nA; cB = nB; ++ui;
        if constexpr (ALIGN_EPI) { if (wr == 1) PG8_BAR; }
    }
    PG8_WAIT_V(0);
    if constexpr (!ALIGN_EPI) { if (wr == 0) PG8_BAR; }
    PG8_BAR;
    if constexpr (Epi::AFTER_DRAIN) { E.fused(acc, cur, wr, wc, fr, fq, lds, wid, lane); S.done(cur); }
#undef PG8_SA
#undef PG8_SB
#undef PG8_STAGE
#undef PG8_LDA
#undef PG8_LDB
#undef PG8_MMA
#undef PG8_WAIT_V
#undef PG8_WAIT_L
#undef PG8_BAR
#undef PG8_SCHED
}}

struct Args { const float* in[28]; float* out; unsigned char* ws; int lo, hi; };
enum { I_XP = 0, I_XS, I_PP, I_PS, I_SCONV, I_CK, I_CV, I_REL, I_F1N, I_F1G, I_F1U, I_F1D, I_MIXN, I_WIN, I_CONVW, I_QN, I_KN, I_SINK, I_WCO, I_WAO, I_WOUT, I_F2N, I_F2G, I_F2U, I_F2D, I_PLEN, I_WPLE, I_WPG };
constexpr int NWAVES = 8, NTHR = 512;
#define RLX_AGENT __ATOMIC_RELAXED, __HIP_MEMORY_SCOPE_AGENT
constexpr int RING_BYTES = 131072, MISC_OFF = 134144, LDS_BYTES = 135168;

__device__ __forceinline__ void tr_item(const float* src, int srcN, int colA, int colB, const float* gain, int K, bf16_t* dst, int drow0, int k0, LAS float* scr, int lane, int kd0 = -1) {
    if (kd0 < 0) kd0 = k0;
    const float* sp = src + (size_t)k0 * srcN + ((lane < 32) ? colA + lane : colB + lane - 32);
    const float g = gain ? gain[k0 + lane] : 1.0f;
    float v[64];
#pragma unroll
    for (int kk = 0; kk < 64; ++kk) v[kk] = sp[(size_t)kk * srcN];
#pragma unroll
    for (int kk = 0; kk < 64; ++kk) scr[kk * 65 + lane] = v[kk] * __builtin_bit_cast(float, __builtin_amdgcn_readlane(__builtin_bit_cast(int, g), kk));
    asm volatile("s_waitcnt lgkmcnt(0)" ::: "memory");
    const int c = lane & 7;
#pragma unroll
    for (int j = 0; j < 8; ++j) { const int n = (lane >> 3) + 8 * j; const LAS float* s = scr + (8 * c) * 65 + n;
        u32x4 o; o.x = pk2(s[0 * 65], s[1 * 65]); o.y = pk2(s[2 * 65], s[3 * 65]); o.z = pk2(s[4 * 65], s[5 * 65]); o.w = pk2(s[6 * 65], s[7 * 65]);
        *(u32x4*)(dst + (size_t)(drow0 + n) * K + kd0 + 8 * c) = o; }
    asm volatile("s_waitcnt lgkmcnt(0)" ::: "memory");
}
__device__ __forceinline__ float wave_sum(float v) {
#pragma unroll
    for (int o = 1; o < 64; o <<= 1) v += __shfl_xor(v, o);
    return v;
}
__device__ __forceinline__ int win_col(int n0) {
    const int pn = n0 >> 8, r = n0 & 255;
    if (pn < 4) return n0;
    if (pn < 12) return ((r >> 7) ? 2048 : 1024) + 128 * (pn - 4) + (r & 127);
    if (pn < 16) return 3072 + 64 * (4 * (pn - 12) + ((r >> 5) & 3)) + 32 * (r >> 7);
    if (pn == 16) return 4096 + 64 * ((r >> 5) & 3) + 32 * (r >> 7);
    if (pn == 17) return 4352 + r;
    if (pn < 26) return 4608 + 256 * (pn - 18) + r;
    return 6656 + 256 * (pn - 26) + r;
}
enum { J_W1 = 0, J_W1D, J_WIN, J_WCO, J_WAO, J_WOUT, J_W2, J_W2D, J_WPLE, J_WPG };
__device__ __forceinline__ int job_items(int j) { return j == J_W1 || j == J_W2 ? 32 * 128 : j == J_W1D || j == J_W2D ? 64 * 32 : j == J_WIN ? 32 * 136 : j == J_WCO || j == J_WAO ? 16 * 32 : j == J_WPLE ? 4 * 32 : 32 * 32; }
__device__ __forceinline__ void job_item(const Args& a, int j, int r, LAS float* scr, int lane) {
    unsigned char* ws = a.ws;
    if (j == J_W1 || j == J_W2) { const int kb = r / 128, n0 = (r % 128) * 64; const int pn = n0 >> 8, rr = n0 & 255, c0 = 128 * pn + (rr & 127); const bool f2 = (j == J_W2);
        tr_item((rr >> 7) ? a.in[f2 ? I_F2U : I_F1U] : a.in[f2 ? I_F2G : I_F1G], FF, c0, c0 + 32, a.in[f2 ? I_F2N : I_F1N], D, (bf16_t*)(ws + (f2 ? WS_W2 : WS_W1)), n0, kb * 64, scr, lane); }
    else if (j == J_WIN) { const int kb = r / 136, n0 = (r % 136) * 64; tr_item(a.in[I_WIN], NIN, win_col(n0), win_col(n0 + 32), a.in[I_MIXN], D, (bf16_t*)(ws + WS_WIN), n0, kb * 64, scr, lane); }
    else { const int kb = r / 32, n0 = (r % 32) * 64;
        const float* src; const float* gain = nullptr; int K; size_t dst; int kd = kb * 64;
        if (j == J_W1D) { src = a.in[I_F1D]; K = FF; dst = WS_W1D; } else if (j == J_W2D) { src = a.in[I_F2D]; K = FF; dst = WS_W2D; }
        else if (j == J_WCO) { src = a.in[I_WCO]; K = MIXP; dst = WS_WCO; } else if (j == J_WAO) { src = a.in[I_WAO]; K = MIXP; dst = WS_WCO; kd += DC; }
        else if (j == J_WOUT) { src = a.in[I_WOUT]; K = D; dst = WS_WOUT; } else if (j == J_WPLE) { src = a.in[I_WPLE]; K = DPLE; dst = WS_WPLE; }
        else { src = a.in[I_WPG]; K = D; dst = WS_WPG; gain = a.in[I_PLEN]; }
        tr_item(src, D, n0, n0 + 32, gain, K, (bf16_t*)(ws + dst), n0, kb * 64, scr, lane, kd); }
}
__device__ __forceinline__ void convert_jobs(const Args& a, int j0, int j1, int w, int nw, LAS unsigned char* lds, int wave, int lane) {
    LAS float* scr = (LAS float*)(lds + wave * 16640);
    int base = 0;
    for (int j = j0; j < j1; ++j) { const int ni = job_items(j);
        for (int it = (w + nw - (base % nw)) % nw; it < ni; it += nw) job_item(a, j, it, scr, lane);
        base += ni; }
}
__device__ __forceinline__ void prologue(const Args& a, LAS unsigned char* lds, int gw, int NGW, int wave, int lane) {
    unsigned char* ws = a.ws;
    if (NGW == 256 * NWAVES) {
        convert_jobs(a, J_W1, J_W1 + 1, gw, NGW, lds, wave, lane);
        convert_jobs(a, J_WPLE, J_WPG + 1, gw, NGW, lds, wave, lane);
    } else convert_jobs(a, J_W1, J_WPG + 1, gw, NGW, lds, wave, lane);
    auto xrow = [&](int m) -> const float* { return (m < MP) ? a.in[I_XP] + (size_t)m * D : a.in[I_XS] + (size_t)(m - MP) * D; };
    auto prow = [&](int m) -> const float* { return (m < MP) ? a.in[I_PP] + (size_t)m * DPLE : a.in[I_PS] + (size_t)(m - MP) * DPLE; };
    auto finish = [&](int m, const f32x4 (&v)[8], const f32x4& p) {
        float s = 0.f;
#pragma unroll
        for (int j = 0; j < 8; ++j) s += (v[j][0] * v[j][0] + v[j][1] * v[j][1]) + (v[j][2] * v[j][2] + v[j][3] * v[j][3]);
        const float ms = wave_sum(s) * (1.0f / D) + EPS; const float rstd = rsqrtf(ms);
        if (lane == 0) ((float*)(ws + WS_RMS0))[m] = sqrtf(ms);
        u32x2* o = (u32x2*)((bf16_t*)(ws + WS_XN) + (size_t)m * D);
#pragma unroll
        for (int j = 0; j < 8; ++j) { u32x2 w; w.x = pk2(v[j][0] * rstd, v[j][1] * rstd); w.y = pk2(v[j][2] * rstd, v[j][3] * rstd); o[lane + 64 * j] = w; }
        u32x2 w; w.x = pk2(p[0], p[1]); w.y = pk2(p[2], p[3]);
        ((u32x2*)((bf16_t*)(ws + WS_PE) + (size_t)m * DPLE))[lane] = w;
    };
    for (int m = gw; m < M; m += 2 * NGW) {
        const int m2 = m + NGW; const bool two = m2 < M;
        f32x4 v1[8], v2[8], p1, p2;
        const float* x1 = xrow(m); const float* x2 = xrow(two ? m2 : m);
#pragma unroll
        for (int j = 0; j < 8; ++j) v1[j] = ((const f32x4*)x1)[lane + 64 * j];
#pragma unroll
        for (int j = 0; j < 8; ++j) v2[j] = ((const f32x4*)x2)[lane + 64 * j];
        p1 = ((const f32x4*)prow(m))[lane]; p2 = ((const f32x4*)prow(two ? m2 : m))[lane];
        finish(m, v1, p1);
        if (two) finish(m2, v2, p2);
    }
}

constexpr int KS_STRIDE = 144, VT_STRIDE = 400, ATT_KS = 0, ATT_VT = 28672, ATT_LUT = 55296;
__device__ __forceinline__ int t5_bucket(int rel) {
    const int n = rel < 0 ? -rel : rel; int b = rel > 0 ? 16 : 0;
    if (n < 8) return b + n;
    int lg = 8 + (31 - __builtin_clz((unsigned)(n * n))) - 6; if (lg > 15) lg = 15;
    return b + lg;
}
__device__ __forceinline__ void attn_conv_phase(const Args& a, LAS unsigned char* lds) {
    int tid = threadIdx.x; asm volatile("" : "+v"(tid));
    const int lane = tid & 63, wave = __builtin_amdgcn_readfirstlane(tid >> 6);
    unsigned char* ws = a.ws;
    const bf16_t* Qb = (const bf16_t*)(ws + WS_Q); bf16_t* Ob = (bf16_t*)(ws + WS_O); const bf16_t* Kb = (const bf16_t*)(ws + WS_K); const bf16_t* Vb = (const bf16_t*)(ws + WS_V);
    LAS bf16_t* Ks = (LAS bf16_t*)(lds + ATT_KS); LAS bf16_t* Vt = (LAS bf16_t*)(lds + ATT_VT); LAS float* lut = (LAS float*)(lds + ATT_LUT);
    const int g = wave >> 1, qh = wave & 1, q = lane & 31, h = lane >> 5;
    for (int uid = blockIdx.x; uid < 1024 + 64; uid += gridDim.x) {
        const bool smp = uid >= 1024; int b, c, kvh;
        if (!smp) { kvh = uid & 3; c = (uid >> 2) & 127; b = uid >> 9; } else { const int s = uid - 1024; kvh = s & 3; b = s >> 2; c = 0; }
        auto ldrow = [&](bool isv, int j, int ck) -> u32x4 {
            u32x4 w = {0u, 0u, 0u, 0u};
            if (!smp) { const int pos = 64 * (c - 2) + j; if (pos >= 0) w = *(const u32x4*)((isv ? Vb : Kb) + (size_t)(b * SEQ + pos) * 256 + kvh * 64 + 8 * ck); }
            else if (j < 128) { const float* cp = a.in[isv ? I_CV : I_CK] + ((size_t)(b * 128 + j) * 4 + kvh) * 64 + 8 * ck; const f32x4 x0 = *(const f32x4*)cp, x1 = *(const f32x4*)(cp + 4);
                w.x = pk2(x0[0], x0[1]); w.y = pk2(x0[2], x0[3]); w.z = pk2(x1[0], x1[1]); w.w = pk2(x1[2], x1[3]); }
            else if (j < 144) w = *(const u32x4*)((isv ? Vb : Kb) + (size_t)(MP + b * 16 + (j - 128)) * 256 + kvh * 64 + 8 * ck);
            return w; };
        u32x4 kw[3], vw[4];
#pragma unroll
        for (int i = 0; i < 3; ++i) { const int idx = tid + i * NTHR; kw[i] = ldrow(false, idx >> 3, idx & 7); }
        const int vjg = tid >> 3, vck = tid & 7;
        if (tid < 384) {
#pragma unroll
            for (int i = 0; i < 4; ++i) vw[i] = ldrow(true, 4 * vjg + i, vck); }
#pragma unroll
        for (int i = 0; i < 3; ++i) { const int idx = tid + i * NTHR; *(LAS u32x4*)((LAS unsigned char*)Ks + (idx >> 3) * KS_STRIDE + (idx & 7) * 16) = kw[i]; }
        if (tid < 384) {
            LAS unsigned char* vp = (LAS unsigned char*)Vt + (8 * vck) * VT_STRIDE + 8 * vjg;
#pragma unroll
            for (int e = 0; e < 4; ++e) {
                const unsigned w0 = e == 0 ? vw[0].x : e == 1 ? vw[0].y : e == 2 ? vw[0].z : vw[0].w, w1 = e == 0 ? vw[1].x : e == 1 ? vw[1].y : e == 2 ? vw[1].z : vw[1].w;
                const unsigned w2 = e == 0 ? vw[2].x : e == 1 ? vw[2].y : e == 2 ? vw[2].z : vw[2].w, w3 = e == 0 ? vw[3].x : e == 1 ? vw[3].y : e == 2 ? vw[3].z : vw[3].w;
                u32x2 lo, hi; lo.x = (w0 & 0xffffu) | (w1 << 16); lo.y = (w2 & 0xffffu) | (w3 << 16); hi.x = (w0 >> 16) | (w1 & 0xffff0000u); hi.y = (w2 >> 16) | (w3 & 0xffff0000u);
                *(LAS u32x2*)(vp + (2 * e) * VT_STRIDE) = lo; *(LAS u32x2*)(vp + (2 * e + 1) * VT_STRIDE) = hi;
            }
        }
        for (int idx = tid; idx < 1024; idx += NTHR) { const int gg = idx >> 8, r = idx & 255; lut[idx] = a.in[I_REL][t5_bucket(r - 191) * 16 + 4 * kvh + gg] * 1.44269504f; }
        const int iq = smp ? (q & 15) : 32 * qh + q;
        const size_t qrow = smp ? (size_t)(MP + b * 16 + iq) : (size_t)(b * SEQ + 64 * c + iq);
        const bf16_t* qp = Qb + qrow * 1024 + (4 * kvh + g) * 64; bf16_t* op = Ob + qrow * MIXP + (4 * kvh + g) * 64;
        bf16x8 qf[4];
#pragma unroll
        for (int s = 0; s < 4; ++s) qf[s] = *(const bf16x8*)(qp + 16 * s + 8 * h);
        const float sink = a.in[I_SINK][4 * kvh + g] * 1.44269504f;
        __syncthreads();
        if (!(smp && qh)) {
            f32x16 st[6];
#pragma unroll
            for (int kt = 0; kt < 6; ++kt) {
#pragma unroll
                for (int i = 0; i < 16; ++i) st[kt][i] = 0.f;
#pragma unroll
                for (int s = 0; s < 4; ++s) {
                    const bf16x8 kf = *(const LAS bf16x8*)((const LAS unsigned char*)Ks + (32 * kt + q) * KS_STRIDE + (16 * s + 8 * h) * 2);
                    st[kt] = __builtin_amdgcn_mfma_f32_32x32x16_bf16(kf, qf[s], st[kt], 0, 0, 0);
                }
            }
            const int kmin = smp ? 0 : (c >= 2 ? 0 : 128 - 64 * c), kmax = smp ? 144 : 192; const bool need_mask = smp || c < 2;
#pragma unroll
            for (int kt = 0; kt < 6; ++kt)
#pragma unroll
                for (int i = 0; i < 16; ++i) { const int key = 32 * kt + 8 * (i >> 2) + 4 * h + (i & 3); st[kt][i] = st[kt][i] * (0.125f * 1.44269504f) + lut[g * 256 + key - iq + 63]; }
            if (need_mask) {
#pragma unroll
                for (int kt = 0; kt < 6; ++kt)
#pragma unroll
                    for (int i = 0; i < 16; ++i) { const int key = 32 * kt + 8 * (i >> 2) + 4 * h + (i & 3); if (key < kmin || key >= kmax) st[kt][i] = -1e30f; }
            }
            float mx = -3.0e38f;
#pragma unroll
            for (int kt = 0; kt < 6; ++kt)
#pragma unroll
                for (int i = 0; i < 16; ++i) mx = fmaxf(mx, st[kt][i]);
            mx = fmaxf(mx, __shfl_xor(mx, 32)); mx = fmaxf(mx, sink);
            float l = 0.f;
#pragma unroll
            for (int kt = 0; kt < 6; ++kt)
#pragma unroll
                for (int i = 0; i < 16; ++i) { const float e = __builtin_amdgcn_exp2f(st[kt][i] - mx); st[kt][i] = e; l += e; }
            l += __shfl_xor(l, 32); l += __builtin_amdgcn_exp2f(sink - mx);
            f32x16 ot[2];
#pragma unroll
            for (int i = 0; i < 16; ++i) { ot[0][i] = 0.f; ot[1][i] = 0.f; }
#pragma unroll
            for (int kt = 0; kt < 6; ++kt)
#pragma unroll
                for (int s = 0; s < 2; ++s) {
                    u32x4 pw; pw.x = pk2(st[kt][8 * s + 0], st[kt][8 * s + 1]); pw.y = pk2(st[kt][8 * s + 2], st[kt][8 * s + 3]); pw.z = pk2(st[kt][8 * s + 4], st[kt][8 * s + 5]); pw.w = pk2(st[kt][8 * s + 6], st[kt][8 * s + 7]);
                    const bf16x8 pf = __builtin_bit_cast(bf16x8, pw);
#pragma unroll
                    for (int dt = 0; dt < 2; ++dt) {
                        const LAS unsigned char* vp = (const LAS unsigned char*)Vt + (32 * dt + q) * VT_STRIDE + (32 * kt + 16 * s + 4 * h) * 2;
                        const s16x4 lo = *(const LAS s16x4*)vp, hi = *(const LAS s16x4*)(vp + 16);
                        const bf16x8 vf = {lo[0], lo[1], lo[2], lo[3], hi[0], hi[1], hi[2], hi[3]};
                        ot[dt] = __builtin_amdgcn_mfma_f32_32x32x16_bf16(vf, pf, ot[dt], 0, 0, 0);
                    }
                }
            const float inv = 1.0f / l;
            if (!smp || q < 16) {
#pragma unroll
                for (int dt = 0; dt < 2; ++dt)
#pragma unroll
                    for (int gq = 0; gq < 4; ++gq) {
                        u32x2 w; w.x = pk2(ot[dt][4 * gq + 0] * inv, ot[dt][4 * gq + 1] * inv); w.y = pk2(ot[dt][4 * gq + 2] * inv, ot[dt][4 * gq + 3] * inv);
                        *(u32x2*)(op + 32 * dt + 8 * gq + 4 * h) = w;
                    }
            }
        }
        __syncthreads();
    }
    {
        const bf16_t* CB = (const bf16_t*)(ws + WS_CB); bf16_t* CCU = (bf16_t*)(ws + WS_CCU); const bf16_t* U = (const bf16_t*)(ws + WS_U);
        const int ch = (tid & 127) * 8;
        float w0[8], w1[8], w2[8];
#pragma unroll
        for (int e = 0; e < 8; ++e) { w0[e] = a.in[I_CONVW][ch + e]; w1[e] = a.in[I_CONVW][DC + ch + e]; w2[e] = a.in[I_CONVW][2 * DC + ch + e]; }
        int rbeg, rend;
        if (gridDim.x == 256) { const int cc = blockIdx.x; if (cc < 64) { rbeg = cc * 44; rend = rbeg + 44; } else { rbeg = 64 * 44 + (cc - 64) * 72; rend = rbeg + 72; } }
        else { const int per = (M + gridDim.x - 1) / gridDim.x; rbeg = blockIdx.x * per; rend = rbeg + per < M ? rbeg + per : M; }
#pragma unroll 2
        for (int row = rbeg + (tid >> 7); row < rend; row += 4) {
            int t, bb; const bool smp = row >= MP;
            if (!smp) { t = row & (SEQ - 1); bb = row >> 13; } else { t = row & 15; bb = (row - MP) >> 4; }
            const u32x4 cb = *(const u32x4*)(CB + (size_t)row * DC + ch), u0 = *(const u32x4*)(U + (size_t)row * DC + ch);
            float p1[8], p2[8];
            if (t >= 1) { const u32x4 x = *(const u32x4*)(U + (size_t)(row - 1) * DC + ch); p1[0] = bflo(x.x); p1[1] = bfhi(x.x); p1[2] = bflo(x.y); p1[3] = bfhi(x.y); p1[4] = bflo(x.z); p1[5] = bfhi(x.z); p1[6] = bflo(x.w); p1[7] = bfhi(x.w); }
            else if (smp) { const float* sp = a.in[I_SCONV] + ((size_t)bb * 2 + 1) * DC + ch;
#pragma unroll
                for (int e = 0; e < 8; ++e) p1[e] = sp[e]; }
            else {
#pragma unroll
                for (int e = 0; e < 8; ++e) p1[e] = 0.f; }
            if (t >= 2) { const u32x4 x = *(const u32x4*)(U + (size_t)(row - 2) * DC + ch); p2[0] = bflo(x.x); p2[1] = bfhi(x.x); p2[2] = bflo(x.y); p2[3] = bfhi(x.y); p2[4] = bflo(x.z); p2[5] = bfhi(x.z); p2[6] = bflo(x.w); p2[7] = bfhi(x.w); }
            else if (smp) { const float* sp = a.in[I_SCONV] + ((size_t)bb * 2 + t) * DC + ch;
#pragma unroll
                for (int e = 0; e < 8; ++e) p2[e] = sp[e]; }
            else {
#pragma unroll
                for (int e = 0; e < 8; ++e) p2[e] = 0.f; }
            float uc[8] = {bflo(u0.x), bfhi(u0.x), bflo(u0.y), bfhi(u0.y), bflo(u0.z), bfhi(u0.z), bflo(u0.w), bfhi(u0.w)};
            float cf[8] = {bflo(cb.x), bfhi(cb.x), bflo(cb.y), bfhi(cb.y), bflo(cb.z), bfhi(cb.z), bflo(cb.w), bfhi(cb.w)};
            float o[8];
#pragma unroll
            for (int e = 0; e < 8; ++e) o[e] = cf[e] * (w0[e] * p2[e] + w1[e] * p1[e] + w2[e] * uc[e]);
            u32x4 w; w.x = pk2(o[0], o[1]); w.y = pk2(o[2], o[3]); w.z = pk2(o[4], o[5]); w.w = pk2(o[6], o[7]);
            *(u32x4*)(CCU + (size_t)row * MIXP + ch) = w;
        }
    }
}

#define XB_TMO      128
#define XB_XCNT(j)  (256  + 64 * (j))
#define XB_XSUB(j)  (1280 + 64 * (j))
#define XB_XGEN(j)  (2304 + 64 * (j))
#define XB_TOP      3328
#define XB_TOPGEN   3392
#define XCD_BAR_WORDS 3456
#define XB_SPIN_CAP (1u << 18)

__device__ __forceinline__ unsigned xb_ld(unsigned* p)              { return __hip_atomic_load(p, __ATOMIC_RELAXED, __HIP_MEMORY_SCOPE_AGENT); }
__device__ __forceinline__ unsigned xb_add(unsigned* p, unsigned v) { return __hip_atomic_fetch_add(p, v, __ATOMIC_RELAXED, __HIP_MEMORY_SCOPE_AGENT); }
__device__ __forceinline__ unsigned xb_xcc_id() { return (unsigned)__builtin_amdgcn_s_getreg((3 << 11) | 20) & 0xFu; }
#define XB_SPIN(cond, bar) do { unsigned _sp = 0; while (cond) { __builtin_amdgcn_s_sleep(1); \
    if ((++_sp & 255u) == 0u) { if (xb_ld(&(bar)[XB_TMO])) break; if (_sp > XB_SPIN_CAP) { atomicAdd(&(bar)[XB_TMO], 1u); break; } } } } while (0)

struct XcdBarrier {
    unsigned* bar; unsigned x;
    volatile LAS unsigned* st;
};

__device__ __forceinline__ XcdBarrier xcd_barrier_post(unsigned* bar, volatile LAS unsigned* st) {
    XcdBarrier b; b.bar = bar; b.x = xb_xcc_id(); b.st = st;
    if (threadIdx.x == 0) (void)xb_add(&bar[XB_XCNT(b.x)], 1u);
    return b;
}
__device__ __forceinline__ void xcd_barrier_complete(unsigned* bar, unsigned x, unsigned& nloc, unsigned& nx) {
    const unsigned G = gridDim.x * gridDim.y * gridDim.z;
    unsigned sum, cnt, mine, sp = 0u;
    for (;;) {
        sum = 0u; cnt = 0u; mine = 0u;
#pragma unroll
        for (unsigned j = 0; j < 16; ++j) { const unsigned c = xb_ld(&bar[XB_XCNT(j)]); sum += c; cnt += (c > 0u) ? 1u : 0u; mine = (j == x) ? c : mine; }
        if (sum == G) break;
        __builtin_amdgcn_s_sleep(1);
        if ((++sp & 255u) == 0u) { if (xb_ld(&bar[XB_TMO])) break; if (sp > XB_SPIN_CAP) { atomicAdd(&bar[XB_TMO], 1u); break; } }
    }
    nloc = mine > 0u ? mine : 1u; nx = cnt > 0u ? cnt : 1u;
}

__device__ __forceinline__ void xcd_barrier(const XcdBarrier& b) {
    asm volatile("s_waitcnt vmcnt(0)" ::: "memory");
    __syncthreads();
    if (threadIdx.x == 0) {
        unsigned* bar = b.bar;
        __builtin_amdgcn_s_waitcnt(0);
        unsigned nloc = b.st[0], nx = b.st[1];
        if (nloc == 0u) { xcd_barrier_complete(bar, b.x, nloc, nx); b.st[0] = nloc; b.st[1] = nx; }
        const unsigned old = xb_add(&bar[XB_XSUB(b.x)], 1u);
        const unsigned gen = old / nloc;
        if (old + 1u == (gen + 1u) * nloc) {
            __builtin_amdgcn_fence(__ATOMIC_RELEASE, "agent");
            asm volatile("s_waitcnt vmcnt(0)" ::: "memory");
            const unsigned og = xb_add(&bar[XB_TOP], 1u);
            const unsigned tg = og / nx;
            if (og + 1u == (tg + 1u) * nx) xb_add(&bar[XB_TOPGEN], 1u);
            else XB_SPIN(xb_ld(&bar[XB_TOPGEN]) == tg, bar);
            __builtin_amdgcn_fence(__ATOMIC_ACQUIRE, "agent");
            xb_add(&bar[XB_XGEN(b.x)], 1u);
            asm volatile("s_waitcnt vmcnt(0)" ::: "memory");
        } else {
            XB_SPIN(xb_ld(&bar[XB_XGEN(b.x)]) == gen, bar);
            __builtin_amdgcn_fence(__ATOMIC_ACQUIRE, "agent");
            asm volatile("s_waitcnt vmcnt(0)" ::: "memory");
        }
    }
    __syncthreads();
}

constexpr int NSTEPS = 12;
__global__ void __launch_bounds__(NTHR, 2) fwd_kernel(Args args) {
    extern __shared__ __attribute__((aligned(16))) unsigned char lds_raw[];
    LAS unsigned char* lds = (LAS unsigned char*)lds_raw;
    const int tid = threadIdx.x, lane = tid & 63, wave = __builtin_amdgcn_readfirstlane(tid >> 6);
    const int G = gridDim.x;
    unsigned char* ws = args.ws;
    volatile LAS unsigned* MISC = (volatile LAS unsigned*)(lds + MISC_OFF);
    if (tid < 64) MISC[tid] = 0u;
    __syncthreads();
    const bool one_launch = (args.hi - args.lo) > 1;
    XcdBarrier xbar; xbar.bar = (unsigned*)(ws + WS_CTL) + CW_BAR; xbar.x = 0; xbar.st = nullptr;
    if (one_launch) xbar = xcd_barrier_post((unsigned*)(ws + WS_CTL) + CW_BAR, MISC + 8);
    if (args.lo < 0) cg::this_grid().sync();
#define SEAM(step, sync_after) do { if ((step) + 1 < args.hi) { if (sync_after) xcd_barrier(xbar); else { asm volatile("s_waitcnt vmcnt(0)" ::: "memory"); __syncthreads(); } } } while (0)
    if (args.lo <= 0 && 0 < args.hi) {
        const int vcu = (G % 8 == 0) ? (blockIdx.x % 8) * (G / 8) + blockIdx.x / 8 : blockIdx.x;
        prologue(args, lds, vcu * NWAVES + wave, G * NWAVES, wave, lane);
        SEAM(0, true);
    }
    for (int step = (args.lo > 1 ? args.lo : 1); step < (args.hi < 4 ? args.hi : 4); ++step) {
        pg8::Gemm g; pg8::Epi E;
        E.ws = ws; E.dout = args.out; E.scale = 1.f; E.ssp_in_off = 0; E.ssp_out_off = 0; E.step = step; E.xp = nullptr; E.xs = nullptr; E.qn = args.in[I_QN]; E.kn = args.in[I_KN];
        g.M = M;
        if (step == 1) { g.A = (const bf16_t*)(ws + WS_XN); g.Bt = (const bf16_t*)(ws + WS_W1); g.N = 2 * FF; g.K = D; E.mode = pg8::MODE_GU; }
        else if (step == 2) { g.A = (const bf16_t*)(ws + WS_A1); g.Bt = (const bf16_t*)(ws + WS_W1D); g.N = D; g.K = FF; E.mode = pg8::MODE_RES; E.scale = 0.5f; E.xp = args.in[I_XP]; E.xs = args.in[I_XS];
                 E.ssp_out_off = (unsigned)WS_SSP1; }
        else { g.A = (const bf16_t*)(ws + WS_HB); g.Bt = (const bf16_t*)(ws + WS_WIN); g.N = NIN; g.K = D; E.mode = pg8::MODE_IN; E.ssp_in_off = (unsigned)WS_SSP1; }
        E.mypm = -1; E.rtab = (const LAS float*)(lds + RING_BYTES);
        if ((E.ssp_in_off || E.xp) && G == 256) {
            const int c_ = (int)blockIdx.x, pmq = 8 * (c_ & 7) + ((c_ >> 3) & 7); int t_ = threadIdx.x; asm volatile("" : "+v"(t_));
            if (E.xp && t_ >= 256) ((LAS float*)(lds + RING_BYTES))[t_] = ((const float*)(ws + WS_RMS0))[pmq * 256 + t_ - 256];
            if (E.ssp_in_off && t_ < 256) { const float* p_ = (const float*)(ws + E.ssp_in_off) + (size_t)(pmq * 256 + t_); float s_ = 0.f;
#pragma unroll
                for (int k_ = 0; k_ < 32; k_ += 4) s_ += (p_[(size_t)k_ * M] + p_[(size_t)(k_ + 1) * M]) + (p_[(size_t)(k_ + 2) * M] + p_[(size_t)(k_ + 3) * M]);
                ((LAS float*)(lds + RING_BYTES))[t_] = rsqrtf(s_ * (1.0f / D) + EPS); }
            __syncthreads(); E.mypm = pmq;
        }
        pg8::PhaseOrder S; const int nsplit = (step == 3) ? 1 : (g.N == D ? 8 : 4); E.S = nsplit; S.init(g.N, g.K, nsplit, G, (int)blockIdx.x);
        pg8::gemm_phase<pg8::Epi, pg8::PhaseOrder, true, true>(lds, g, S, E);
        {
            const int c = (int)blockIdx.x; int tlane = threadIdx.x; asm volatile("" : "+v"(tlane)); tlane &= 63;
            if (G != 256) {} else if (step == 1 && c >= 128) convert_jobs(args, J_W1D, J_W1D + 1, (c - 128) * NWAVES + wave, 128 * NWAVES, lds, wave, tlane);
            else if (step == 2 && c >= 64) convert_jobs(args, J_WIN, J_WIN + 1, (c - 64) * NWAVES + wave, 192 * NWAVES, lds, wave, tlane);
            else if (step == 3 && c >= 128 && c < 222) convert_jobs(args, J_WCO, J_WOUT + 1, (c - 128) * NWAVES + wave, 94 * NWAVES, lds, wave, tlane);
        }
        SEAM(step, true);
    }
    if (args.lo <= 4 && 4 < args.hi) {
        attn_conv_phase(args, lds);
        SEAM(4, true);
    }
    for (int step = (args.lo > 5 ? args.lo : 5); step < args.hi; ++step) {
        if (step == 6) continue;
        bool sync_after = true;
        pg8::Gemm g; pg8::Epi E;
        E.ws = ws; E.dout = args.out; E.scale = 1.f; E.ssp_in_off = 0; E.ssp_out_off = 0; E.step = step; E.xp = nullptr; E.xs = nullptr; E.qn = nullptr; E.kn = nullptr;
        g.M = M;
        switch (step) {
        case 5:  g.A = (const bf16_t*)(ws + WS_CCU); g.Bt = (const bf16_t*)(ws + WS_WCO); g.N = D; g.K = MIXP; E.mode = pg8::MODE_MG2; break;
        case 7:  g.A = (const bf16_t*)(ws + WS_MG); g.Bt = (const bf16_t*)(ws + WS_WOUT); g.N = D; g.K = D; E.mode = pg8::MODE_RES; E.ssp_out_off = (unsigned)WS_SSP2; break;
        case 8:  g.A = (const bf16_t*)(ws + WS_HB); g.Bt = (const bf16_t*)(ws + WS_W2); g.N = 2 * FF; g.K = D; E.mode = pg8::MODE_GU; E.ssp_in_off = (unsigned)WS_SSP2; break;
        case 9:  g.A = (const bf16_t*)(ws + WS_A1); g.Bt = (const bf16_t*)(ws + WS_W2D); g.N = D; g.K = FF; E.mode = pg8::MODE_RES; E.scale = 0.5f; E.ssp_out_off = (unsigned)WS_SSP3; sync_after = false; break;
        case 10: g.A = (const bf16_t*)(ws + WS_PE); g.Bt = (const bf16_t*)(ws + WS_WPLE); g.N = D; g.K = DPLE; E.mode = pg8::MODE_F32; break;
        default: g.A = (const bf16_t*)(ws + WS_HB); g.Bt = (const bf16_t*)(ws + WS_WPG); g.N = D; g.K = D; E.mode = pg8::MODE_OUT; E.ssp_in_off = (unsigned)WS_SSP3; break;
        }
        E.mypm = -1; E.rtab = (const LAS float*)(lds + RING_BYTES);
        if ((E.ssp_in_off || E.xp) && G == 256) {
            const int c_ = (int)blockIdx.x, pmq = 8 * (c_ & 7) + ((c_ >> 3) & 7); int t_ = threadIdx.x; asm volatile("" : "+v"(t_));
            if (E.xp && t_ >= 256) ((LAS float*)(lds + RING_BYTES))[t_] = ((const float*)(ws + WS_RMS0))[pmq * 256 + t_ - 256];
            if (E.ssp_in_off && t_ < 256) { const float* p_ = (const float*)(ws + E.ssp_in_off) + (size_t)(pmq * 256 + t_); float s_ = 0.f;
#pragma unroll
                for (int k_ = 0; k_ < 32; k_ += 4) s_ += (p_[(size_t)k_ * M] + p_[(size_t)(k_ + 1) * M]) + (p_[(size_t)(k_ + 2) * M] + p_[(size_t)(k_ + 3) * M]);
                ((LAS float*)(lds + RING_BYTES))[t_] = rsqrtf(s_ * (1.0f / D) + EPS); }
            __syncthreads(); E.mypm = pmq;
        }
        pg8::PhaseOrder S; const int nsplit = (step == 10) ? 1 : (g.N == D ? 8 : 4); E.S = nsplit; S.init(g.N, g.K, nsplit, G, (int)blockIdx.x); S.lin = (step == 10 && G == 256);
        pg8::gemm_phase<pg8::Epi, pg8::PhaseOrder, true, true>(lds, g, S, E);
        {   const int c = (int)blockIdx.x; int tlane = threadIdx.x; asm volatile("" : "+v"(tlane)); tlane &= 63;
            if (G != 256) {} else if (step == 5 && c >= 64) convert_jobs(args, J_W2, J_W2 + 1, (c - 64) * NWAVES + wave, 192 * NWAVES, lds, wave, tlane);
            else if (step == 8 && c >= 128) convert_jobs(args, J_W2D, J_W2D + 1, (c - 128) * NWAVES + wave, 128 * NWAVES, lds, wave, tlane);
        }
        SEAM(step, sync_after);
    }
#undef SEAM
}

#ifndef N_LAUNCHES
#define N_LAUNCHES 1
#endif
extern "C" void kernel_launch(void* const* d_in, const int* in_sizes, int n_in, void* d_out, int out_size, void* d_ws, size_t ws_size, hipStream_t stream) {
    static int grid = 0;
    if (grid == 0) {
        if (n_in != 28 || (size_t)out_size != O_END || ws_size < WS_END) { fprintf(stderr, "kernel_launch: unexpected shapes: n_in %d out %d ws %zu (need %zu)\n", n_in, out_size, ws_size, (size_t)WS_END); grid = -1; return; }
        int dev = 0, cus = 0, per_cu = 0;
        hipGetDevice(&dev); hipDeviceGetAttribute(&cus, hipDeviceAttributeMultiprocessorCount, dev);
        if (hipFuncSetAttribute((const void*)fwd_kernel, hipFuncAttributeMaxDynamicSharedMemorySize, LDS_BYTES) != hipSuccess) { fprintf(stderr, "kernel_launch: hipFuncSetAttribute failed\n"); grid = -1; return; }
        if (hipOccupancyMaxActiveBlocksPerMultiprocessor(&per_cu, (const void*)fwd_kernel, NTHR, LDS_BYTES) != hipSuccess || per_cu < 1) { fprintf(stderr, "kernel_launch: occupancy query says %d\n", per_cu); per_cu = 1; }
        (void)hipGetLastError();
        grid = cus * 1;
        if (grid <= 0) grid = 256;
    }
    if (grid < 0) return;
    Args a{};
    for (int i = 0; i < 28; ++i) a.in[i] = (const float*)d_in[i];
    a.out = (float*)d_out; a.ws = (unsigned char*)d_ws;
#if N_LAUNCHES == 1
    if (hipMemsetAsync((char*)d_ws + WS_CTL, 0, CTL_ZERO_BYTES, stream) != hipSuccess) { fprintf(stderr, "kernel_launch: memset failed\n"); return; }
    a.lo = 0; a.hi = NSTEPS;
    void* kargs[] = {&a};
    hipError_t e = hipLaunchCooperativeKernel((const void*)fwd_kernel, dim3(grid), dim3(NTHR), kargs, LDS_BYTES, stream);
    if (e != hipSuccess) fprintf(stderr, "kernel_launch: cooperative launch failed: %s (grid %d)\n", hipGetErrorString(e), grid);
#else
    for (int s = 0; s < NSTEPS; ++s) { a.lo = s; a.hi = s + 1; hipLaunchKernelGGL(fwd_kernel, dim3(grid), dim3(NTHR), LDS_BYTES, stream, a); }
#endif
}
```

```cpp
#include <hip/hip_runtime.h>
#include <hip/hip_cooperative_groups.h>
#include <cstdio>
#include <cstdint>
namespace cg = cooperative_groups;

#define LAS __attribute__((address_space(3)))
typedef unsigned short bf16_t;
typedef short bf16x8 __attribute__((ext_vector_type(8)));
typedef short s16x4 __attribute__((ext_vector_type(4)));
typedef float f32x2 __attribute__((ext_vector_type(2)));
typedef float f32x4 __attribute__((ext_vector_type(4)));
typedef float f32x16 __attribute__((ext_vector_type(16)));
typedef unsigned u32x2 __attribute__((ext_vector_type(2)));
typedef unsigned u32x4 __attribute__((ext_vector_type(4)));
typedef __bf16 bf2_t __attribute__((ext_vector_type(2)));

constexpr int MP = 16384, MS = 256, M = MP + MS;
constexpr int D = 2048, FF = 4096, DC = 1024, NIN = 8704, DPLE = 256, SEQ = 8192;
constexpr float EPS = 1e-6f;
constexpr size_t O_CONVP = (size_t)M * D, O_KP = O_CONVP + 4096, O_VP = O_KP + 65536, O_CONVS = O_VP + 65536, O_KS = O_CONVS + 32768, O_VS = O_KS + 65536, O_END = O_VS + 65536;
constexpr size_t MiB = 1u << 20;
constexpr size_t WS_CTL = 0, CTL_ZERO_BYTES = 65536; constexpr int CW_BAR = 1024, CW_SPLIT = 8192;
constexpr size_t WS_RMS0 = 512 * 1024;
constexpr size_t WS_SSP1 = 1 * MiB, WS_SSP2 = 4 * MiB, WS_SSP3 = 7 * MiB, WS_PE = 10 * MiB;
constexpr size_t WS_W1 = 20 * MiB, WS_W1D = 52 * MiB, WS_WIN = 68 * MiB, WS_WCO = 102 * MiB, WS_WAO = 106 * MiB, WS_WOUT = 110 * MiB, WS_W2 = 118 * MiB, WS_W2D = 150 * MiB, WS_WPLE = 166 * MiB, WS_WPG = 167 * MiB;
constexpr size_t ACT65 = (size_t)M * D * 2;
constexpr size_t WS_XN = 176 * MiB, WS_CB = WS_XN, WS_U = WS_XN + ACT65 / 2;
constexpr size_t WS_A1 = WS_XN + ACT65, WS_SGC = WS_A1, WS_SGA = WS_A1 + ACT65 / 2, WS_MG = WS_A1 + ACT65, WS_T = WS_XN;
constexpr size_t WS_HB = WS_A1 + 2 * ACT65, WS_CCU = WS_W1, WS_O = WS_W1 + 2 * DC;
constexpr int MIXP = 2048;
constexpr size_t WS_PART = WS_HB + ACT65;
constexpr size_t WS_Q = WS_HB + ACT65, WS_K = WS_Q + ACT65 / 2, WS_V = WS_K + (size_t)M * 256 * 2, WS_END = WS_V + (size_t)M * 256 * 2;

__device__ __forceinline__ unsigned pk2(float a, float b) { f32x2 v = {a, b}; bf2_t r = __builtin_convertvector(v, bf2_t); return __builtin_bit_cast(unsigned, r); }
__device__ __forceinline__ float bflo(unsigned w) { return __builtin_bit_cast(float, w << 16); }
__device__ __forceinline__ float bfhi(unsigned w) { return __builtin_bit_cast(float, w & 0xffff0000u); }
__device__ __forceinline__ float sigmoidf_(float x) { return __builtin_amdgcn_rcpf(1.0f + __expf(-x)); }
__device__ __forceinline__ unsigned q8x4(f32x4 v) { return (unsigned)(v[0] * 255.0f + 0.5f) | ((unsigned)(v[1] * 255.0f + 0.5f) << 8) | ((unsigned)(v[2] * 255.0f + 0.5f) << 16) | ((unsigned)(v[3] * 255.0f + 0.5f) << 24); }
__device__ __forceinline__ void u8x8(u32x2 w, float (&f)[8]) { f[0] = (float)(w.x & 0xffu); f[1] = (float)((w.x >> 8) & 0xffu); f[2] = (float)((w.x >> 16) & 0xffu); f[3] = (float)(w.x >> 24); f[4] = (float)(w.y & 0xffu); f[5] = (float)((w.y >> 8) & 0xffu); f[6] = (float)((w.y >> 16) & 0xffu); f[7] = (float)(w.y >> 24); }

namespace pg8 {
#define PG8_LAS __attribute__((address_space(3)))
constexpr int BM = 256, BK = 64, HALF = 128, HTB = HALF * BK * 2  , STAGE_BYTES = 8 * HTB, NXCD = 8, WGM = 8;

__host__ __device__ __forceinline__ int lds_byte(int r, int c) { const int st = (r >> 4) * 2 + (c >> 5), rr = r & 15, cc = c & 31, ob = rr * 64 + cc * 2; return st * 1024 + (ob ^ (((ob >> 9) & 1) << 5)); }
__host__ __device__ __forceinline__ void stage_rc(int b, int& R, int& C) { const int st = b / 1024, sb = b % 1024, swz = sb ^ (((sb >> 9) & 1) << 5); R = (st >> 1) * 16 + swz / 64; C = (st & 1) * 32 + (swz % 64) / 2; }
__host__ __device__ __forceinline__ int perm32(int rho) { const int n = rho >> 4, i = rho & 15; return 8 * (i >> 2) + 4 * n + (i & 3); }

struct Unit { int pm, pn, kt0, nt, sp; };
struct Gemm { const bf16_t* A; const bf16_t* Bt; int M, N, K; };

struct StaticOrder {
    int nM, nN, nwg, G, c;
    __host__ __device__ void init(int M_, int N_, int G_, int c_) { nM = M_ / BM; nN = N_ / BM; nwg = nM * nN; G = G_; c = c_; }
    __host__ __device__ bool next(int i, Unit& u) const {
        const long L = (long)i * G + c; if (L >= nwg) return false;
        int wgid = (int)L; { const int q = nwg / NXCD, r = nwg % NXCD, xcd = wgid % NXCD, off = wgid / NXCD; wgid = (xcd < r ? xcd * (q + 1) : r * (q + 1) + (xcd - r) * q) + off; }
        const int nig = WGM * nN, gid = wgid / nig, fm = gid * WGM, gsz = (nM - fm) < WGM ? (nM - fm) : WGM;
        u.pm = fm + ((wgid % nig) % gsz); u.pn = (wgid % nig) / gsz; return true;
    }
    __device__ __forceinline__ void a_ready(const Unit&) const {}
    __device__ __forceinline__ void done(const Unit&) const {}
};
struct PhaseOrder {
    int nNp, nwg, nN, S, ntf, c, G; bool lin;
    __device__ __forceinline__ void init(int N_, int K_, int S_, int G_, int c_) { nN = N_ / BM; nNp = nN; nwg = (MP / BM) * nN; S = S_; ntf = K_ / BK; c = c_; G = G_; lin = false; }
    __device__ __forceinline__ bool next(int i, Unit& u) const {
        if (lin) { const int Ll = (c < 64) ? (i == 0 ? c : 1 << 20) : c + 192 * i; u.pm = Ll >> 3; u.pn = Ll & 7; u.sp = -1; u.nt = ntf; u.kt0 = 0; return Ll < (M / BM) * 8; }
        const int L = i * G + c; const bool isP = L < nwg;
        int wgid = isP ? L : 0; { const int q = nwg / NXCD, r = nwg % NXCD, xcd = wgid % NXCD, off = wgid / NXCD; wgid = (xcd < r ? xcd * (q + 1) : r * (q + 1) + (xcd - r) * q) + off; }
        const int nig = WGM * nN, gid = wgid / nig, fm = gid * WGM;
        const int pm = fm + ((wgid % nig) % WGM), pn = (wgid % nig) / WGM;
        const int np = (nwg - c + G - 1) / G;
        const int x = c & 7, ii = c >> 3, j = G - 1 - c; const bool split = S > 1;
        const bool s8 = (S == 8);
        const bool okS = (i == np) && (split ? (s8 ? ii < nN : ii < nN / 2) : (j < nN));
        const int snt = split ? ntf / S : ntf;
        u.pm = isP ? pm : MP / BM; u.pn = isP ? pn : (split ? (s8 ? ii : (nN / 2) * (x >> 2) + ii) : j);
        const int spx = s8 ? x : (x & 3);
        u.sp = (isP || !split) ? -1 : spx; u.nt = isP ? ntf : snt; u.kt0 = (isP || !split) ? 0 : spx * snt;
        return isP || okS;
    }
    __device__ __forceinline__ void a_ready(const Unit&) const {}
    __device__ __forceinline__ void done(const Unit&) const {}
};

enum { MODE_GU = 0, MODE_RES = 1, MODE_IN = 2, MODE_MG2 = 3, MODE_F32 = 5, MODE_OUT = 6 };
struct Epi {
    static constexpr bool PERM = true, AFTER_DRAIN = false;
    int mode; float scale; int step, S, mypm;
    const PG8_LAS float* rtab;
    unsigned char* ws; float* dout;
    unsigned ssp_in_off, ssp_out_off;
    const float* xp; const float* xs;
    const float* qn; const float* kn;

    __device__ __forceinline__ void operator()(f32x4 (&acc)[2][2][4][2], const Unit& u, int wr, int wc, int fr, int fq) const {
        asm volatile("" : "+v"(fr), "+v"(fq));
        const float* ssp_in = ssp_in_off ? (const float*)(ws + ssp_in_off) : nullptr; float* ssp_out = (float*)(ws + ssp_out_off);
        bf16_t* o16 = (bf16_t*)(ws + (mode == MODE_GU ? WS_A1 : WS_HB)); unsigned* cnt = (unsigned*)(ws + WS_CTL) + CW_SPLIT + step * 512;
        int qsel = -1;
        if (u.sp >= 0) {
            typedef unsigned long long u64;
            const int wv = wr * 4 + wc, lane = fq * 16 + fr;
            f32x4* part = (f32x4*)(ws + WS_PART) + ((size_t)(u.pn * S) * 8 + wv) * 2048 + lane;
#pragma unroll
            for (int ai = 0; ai < 2; ++ai)
#pragma unroll
                for (int bj = 0; bj < 2; ++bj)
#pragma unroll
                    for (int m = 0; m < 4; ++m)
#pragma unroll
                        for (int n = 0; n < 2; ++n) {
                            u64* q = (u64*)(part + (size_t)u.sp * 8 * 2048 + (((ai * 2 + bj) * 4 + m) * 2 + n) * 64); const f32x4 v = acc[ai][bj][m][n];
                            __hip_atomic_store(q, ((u64)__float_as_uint(v[1]) << 32) | __float_as_uint(v[0]), __ATOMIC_RELAXED, __HIP_MEMORY_SCOPE_AGENT);
                            __hip_atomic_store(q + 1, ((u64)__float_as_uint(v[3]) << 32) | __float_as_uint(v[2]), __ATOMIC_RELAXED, __HIP_MEMORY_SCOPE_AGENT);
                        }
            asm volatile("s_waitcnt vmcnt(0)" ::: "memory");
            unsigned* cw = cnt + u.pn * 8 + wv;
            if (lane == 0) __hip_atomic_fetch_add(cw, 1u, __ATOMIC_RELAXED, __HIP_MEMORY_SCOPE_AGENT);
            { unsigned spins = 0; while ((unsigned)__builtin_amdgcn_readfirstlane((int)__hip_atomic_load(cw, __ATOMIC_RELAXED, __HIP_MEMORY_SCOPE_AGENT)) < (unsigned)S) { __builtin_amdgcn_s_sleep(2); if (++spins > (1u << 22)) break; } }
            __builtin_amdgcn_fence(__ATOMIC_ACQUIRE, "agent"); asm volatile("s_waitcnt vmcnt(0)" ::: "memory");
            qsel = u.sp;
            if (S == 8) {
                const int qa = qsel >> 2, qm = qsel & 3;
                f32x4 h[2][2][2];
#pragma unroll
                for (int hf = 0; hf < 2; ++hf) {
                    f32x4 t[4][2][2];
#pragma unroll
                    for (int s = 0; s < 4; ++s)
#pragma unroll
                        for (int bj = 0; bj < 2; ++bj)
#pragma unroll
                            for (int n = 0; n < 2; ++n) t[s][bj][n] = part[(size_t)(4 * hf + s) * 8 * 2048 + (((qa * 2 + bj) * 4 + qm) * 2 + n) * 64];
#pragma unroll
                    for (int bj = 0; bj < 2; ++bj)
#pragma unroll
                        for (int n = 0; n < 2; ++n) h[hf][bj][n] = (t[0][bj][n] + t[1][bj][n]) + (t[2][bj][n] + t[3][bj][n]);
                }
#pragma unroll
                for (int bj = 0; bj < 2; ++bj)
#pragma unroll
                    for (int n = 0; n < 2; ++n) { acc[1][bj][0][n] = h[1][bj][n]; acc[0][bj][0][n] = (mode == MODE_MG2) ? h[0][bj][n] : h[0][bj][n] + h[1][bj][n]; }
            } else {
                const int qa = qsel >> 1, qm = (qsel & 1) * 2;
#pragma unroll
                for (int mm = 0; mm < 2; ++mm) {
                    f32x4 t[4][2][2];
#pragma unroll
                    for (int s = 0; s < 4; ++s)
#pragma unroll
                        for (int bj = 0; bj < 2; ++bj)
#pragma unroll
                            for (int n = 0; n < 2; ++n) t[s][bj][n] = part[(size_t)s * 8 * 2048 + (((qa * 2 + bj) * 4 + qm + mm) * 2 + n) * 64];
#pragma unroll
                    for (int bj = 0; bj < 2; ++bj)
#pragma unroll
                        for (int n = 0; n < 2; ++n) {
                            const f32x4 s01 = t[0][bj][n] + t[1][bj][n], s23 = t[2][bj][n] + t[3][bj][n];
                            acc[1][bj][mm][n] = s23;
                            acc[0][bj][mm][n] = (mode == MODE_MG2) ? s01 : s01 + s23;
                        }
                }
            }
        }
        const int mlim = (S == 8) ? 1 : 2;
#define QSKIP(ai, m) if (qsel >= 0 && ((ai) != 0 || (m) >= mlim)) continue
        const int row0 = u.pm * BM + wr * 64 + fr + (qsel < 0 ? 0 : (S == 8 ? (qsel >> 2) * HALF + (qsel & 3) * 16 : (qsel >> 1) * HALF + (qsel & 1) * 32));
        const int cl = wc * 32 + 8 * fq;
        auto rsf = [&](int row) -> float {
            if (!ssp_in) return 1.0f;
            if (u.pm == mypm) return rtab[row & (BM - 1)];
            const float* p = ssp_in + (size_t)(8 * fq) * M + row;
            float s = ((p[0] + p[(size_t)M]) + (p[2 * (size_t)M] + p[3 * (size_t)M])) + ((p[4 * (size_t)M] + p[5 * (size_t)M]) + (p[6 * (size_t)M] + p[7 * (size_t)M]));
            s += __shfl_xor(s, 16); s += __shfl_xor(s, 32);
            return rsqrtf(s * (1.0f / D) + EPS);
        };
        if (mode == MODE_GU) {
#pragma unroll
            for (int ai = 0; ai < 2; ++ai)
#pragma unroll
                for (int m = 0; m < 4; ++m) {
                    QSKIP(ai, m);
                    const int row = row0 + ai * HALF + m * 16; const float r = rsf(row);
                    float o[8];
#pragma unroll
                    for (int n = 0; n < 2; ++n)
#pragma unroll
                        for (int j = 0; j < 4; ++j) { const float g = acc[ai][0][m][n][j] * r, uu = acc[ai][1][m][n][j] * r; o[4 * n + j] = g * sigmoidf_(g) * uu; }
                    u32x4 w; w.x = pk2(o[0], o[1]); w.y = pk2(o[2], o[3]); w.z = pk2(o[4], o[5]); w.w = pk2(o[6], o[7]);
                    *(u32x4*)(o16 + (size_t)row * FF + u.pn * HALF + cl) = w;
                }
        } else if (mode == MODE_RES) {
            const bf16_t* xb = xp ? (const bf16_t*)(ws + WS_XN) : o16;
            const float* rms0 = (const float*)(ws + WS_RMS0);
#pragma unroll
            for (int ai = 0; ai < 2; ++ai) {
                if (qsel >= 0 && ai != 0) continue;
                f32x4 bb[4][2][2];
#pragma unroll
                for (int m = 0; m < 4; ++m) {
                    if (qsel >= 0 && m >= mlim) continue;
                    const size_t off = (size_t)(row0 + ai * HALF + m * 16) * D + u.pn * BM + cl;
#pragma unroll
                    for (int bj = 0; bj < 2; ++bj) {
                        const u32x4 hb = *(const u32x4*)(xb + off + bj * HALF); bb[m][bj][0] = (f32x4){bflo(hb.x), bfhi(hb.x), bflo(hb.y), bfhi(hb.y)}; bb[m][bj][1] = (f32x4){bflo(hb.z), bfhi(hb.z), bflo(hb.w), bfhi(hb.w)};
                    }
                }
#pragma unroll
                for (int m = 0; m < 4; ++m) {
                    QSKIP(ai, m);
                    const int row = row0 + ai * HALF + m * 16; const size_t off = (size_t)row * D + u.pn * BM + cl; float ss = 0.f;
                    const float bs = xp ? (u.pm == mypm ? rtab[BM + (row & (BM - 1))] : rms0[row]) : 1.0f;
#pragma unroll
                    for (int bj = 0; bj < 2; ++bj) {
                        const f32x4 v0 = bb[m][bj][0] * bs + acc[ai][bj][m][0] * scale, v1 = bb[m][bj][1] * bs + acc[ai][bj][m][1] * scale;
                        u32x4 w; w.x = pk2(v0[0], v0[1]); w.y = pk2(v0[2], v0[3]); w.z = pk2(v1[0], v1[1]); w.w = pk2(v1[2], v1[3]);
                        *(u32x4*)(o16 + off + bj * HALF) = w;
                        ss += (v0[0] * v0[0] + v0[1] * v0[1]) + (v0[2] * v0[2] + v0[3] * v0[3]) + (v1[0] * v1[0] + v1[1] * v1[1]) + (v1[2] * v1[2] + v1[3] * v1[3]);
                    }
                    ss += __shfl_xor(ss, 16); ss += __shfl_xor(ss, 32);
                    if (fq == 0) ssp_out[(size_t)(u.pn * 4 + wc) * M + row] = ss;
                }
            }
        } else if (mode == MODE_IN) {
            const int pn = u.pn;
            if (pn >= 4 && pn < 12) {
                bf16_t* U = (bf16_t*)(ws + WS_U);
#pragma unroll
                for (int ai = 0; ai < 2; ++ai)
#pragma unroll
                    for (int m = 0; m < 4; ++m) {
                    QSKIP(ai, m);
                        const int row = row0 + ai * HALF + m * 16; const float r_ = rsf(row), r2 = r_ * r_; const int col = (pn - 4) * HALF + cl;
                        const f32x4 v0 = acc[ai][0][m][0] * acc[ai][1][m][0] * r2, v1 = acc[ai][0][m][1] * acc[ai][1][m][1] * r2;
                        u32x4 w; w.x = pk2(v0[0], v0[1]); w.y = pk2(v0[2], v0[3]); w.z = pk2(v1[0], v1[1]); w.w = pk2(v1[2], v1[3]);
                        *(u32x4*)(U + (size_t)row * DC + col) = w;
                        float* cs = nullptr;
                        if (row < MP) { const int t = row & (SEQ - 1); if (t >= SEQ - 2) cs = dout + O_CONVP + ((size_t)(row >> 13) * 2 + (t - (SEQ - 2))) * DC + col; }
                        else { const int t = row & 15; if (t >= 14) cs = dout + O_CONVS + ((size_t)((row - MP) >> 4) * 2 + (t - 14)) * DC + col; }
                        if (cs) { *(f32x4*)cs = v0; *(f32x4*)(cs + 4) = v1; }
                    }
            } else if (pn >= 12 && pn < 17) {
                const bool isk = (pn == 16); const float* gn = isk ? kn : qn;
                f32x4 gv[2][2];
#pragma unroll
                for (int bj = 0; bj < 2; ++bj) { gv[bj][0] = *(const f32x4*)(gn + 32 * bj + 8 * fq); gv[bj][1] = *(const f32x4*)(gn + 32 * bj + 8 * fq + 4); }
                bf16_t* O = isk ? (bf16_t*)(ws + WS_K) : (bf16_t*)(ws + WS_Q); const int ldo = isk ? 256 : 1024; const int hcol = (isk ? wc : 4 * (pn - 12) + wc) * 64 + 8 * fq;
#pragma unroll
                for (int ai = 0; ai < 2; ++ai)
#pragma unroll
                    for (int m = 0; m < 4; ++m) {
                    QSKIP(ai, m);
                        const int row = row0 + ai * HALF + m * 16; const float r = rsf(row);
                        f32x4 v[2][2]; float ss = 0.f;
#pragma unroll
                        for (int bj = 0; bj < 2; ++bj)
#pragma unroll
                            for (int n = 0; n < 2; ++n) { v[bj][n] = acc[ai][bj][m][n] * r; ss += (v[bj][n][0] * v[bj][n][0] + v[bj][n][1] * v[bj][n][1]) + (v[bj][n][2] * v[bj][n][2] + v[bj][n][3] * v[bj][n][3]); }
                        ss += __shfl_xor(ss, 16); ss += __shfl_xor(ss, 32);
                        const float hr = rsqrtf(ss * (1.0f / 64.0f) + EPS);
                        float* fo = nullptr;
                        if (isk) { if (row >= MP) fo = dout + O_KS + (size_t)(row - MP) * 256 + wc * 64 + 8 * fq;
                                   else { const int t = row & (SEQ - 1); if (t >= SEQ - 128) fo = dout + O_KP + ((size_t)(row >> 13) * 128 + (t - (SEQ - 128))) * 256 + wc * 64 + 8 * fq; } }
#pragma unroll
                        for (int bj = 0; bj < 2; ++bj) {
                            const f32x4 o0 = v[bj][0] * hr * gv[bj][0], o1 = v[bj][1] * hr * gv[bj][1];
                            u32x4 w; w.x = pk2(o0[0], o0[1]); w.y = pk2(o0[2], o0[3]); w.z = pk2(o1[0], o1[1]); w.w = pk2(o1[2], o1[3]);
                            *(u32x4*)(O + (size_t)row * ldo + hcol + 32 * bj) = w;
                            if (fo) { *(f32x4*)(fo + 32 * bj) = o0; *(f32x4*)(fo + 32 * bj + 4) = o1; }
                        }
                    }
            } else {
                bf16_t* O; int ldo, colt; bool sg = false, isv = false;
                if (pn < 4) { O = (bf16_t*)(ws + WS_CB); ldo = DC; colt = pn * BM; }
                else if (pn == 17) { O = (bf16_t*)(ws + WS_V); ldo = 256; colt = 0; isv = true; }
                else if (pn < 26) { O = (bf16_t*)(ws + WS_SGC); ldo = D; colt = (pn - 18) * BM; sg = true; }
                else { O = (bf16_t*)(ws + WS_SGA); ldo = D; colt = (pn - 26) * BM; sg = true; }
#pragma unroll
                for (int ai = 0; ai < 2; ++ai)
#pragma unroll
                    for (int m = 0; m < 4; ++m) {
                    QSKIP(ai, m);
                        const int row = row0 + ai * HALF + m * 16; const float r = rsf(row);
                        float* fo = nullptr;
                        if (isv) { if (row >= MP) fo = dout + O_VS + (size_t)(row - MP) * 256 + cl;
                                   else { const int t = row & (SEQ - 1); if (t >= SEQ - 128) fo = dout + O_VP + ((size_t)(row >> 13) * 128 + (t - (SEQ - 128))) * 256 + cl; } }
#pragma unroll
                        for (int bj = 0; bj < 2; ++bj) {
                            f32x4 v0 = acc[ai][bj][m][0] * r, v1 = acc[ai][bj][m][1] * r;
                            if (sg) {
#pragma unroll
                                for (int j = 0; j < 4; ++j) { v0[j] = sigmoidf_(v0[j]); v1[j] = sigmoidf_(v1[j]); } }
                            if (sg) { u32x2 q; q.x = q8x4(v0); q.y = q8x4(v1); *(u32x2*)((unsigned char*)O + (size_t)row * D + colt + bj * HALF + cl) = q; }
                            else { u32x4 w; w.x = pk2(v0[0], v0[1]); w.y = pk2(v0[2], v0[3]); w.z = pk2(v1[0], v1[1]); w.w = pk2(v1[2], v1[3]);
                                *(u32x4*)(O + (size_t)row * ldo + colt + bj * HALF + cl) = w; }
                            if (fo) { *(f32x4*)(fo + bj * HALF) = v0; *(f32x4*)(fo + bj * HALF + 4) = v1; }
                        }
                    }
            }
        } else if (mode == MODE_MG2) {
            const unsigned char* SGC = (const unsigned char*)(ws + WS_SGC); const unsigned char* SGA = (const unsigned char*)(ws + WS_SGA); bf16_t* MG = (bf16_t*)(ws + WS_MG);
#pragma unroll
            for (int ai = 0; ai < 2; ++ai) {
                if (qsel >= 0 && ai != 0) continue;
                u32x2 sa[4][2], sc[4][2];
#pragma unroll
                for (int m = 0; m < 4; ++m) {
                    if (qsel >= 0 && m >= mlim) continue;
#pragma unroll
                    for (int bj = 0; bj < 2; ++bj) { const size_t off = (size_t)(row0 + ai * HALF + m * 16) * D + u.pn * BM + bj * HALF + cl; sa[m][bj] = *(const u32x2*)(SGA + off); if (qsel >= 0) sc[m][bj] = *(const u32x2*)(SGC + off); }
                }
#pragma unroll
                for (int m = 0; m < 4; ++m) {
                    QSKIP(ai, m);
                    const int row = row0 + ai * HALF + m * 16;
#pragma unroll
                    for (int bj = 0; bj < 2; ++bj) {
                        const size_t off = (size_t)row * D + u.pn * BM + bj * HALF + cl;
                        float ga[8]; u8x8(sa[m][bj], ga);
                        const f32x4 a0 = acc[ai][bj][m][0], a1 = acc[ai][bj][m][1];
                        float o[8];
                        if (qsel >= 0) {
                            float gc[8]; u8x8(sc[m][bj], gc); const f32x4 b0 = acc[1][bj][m][0], b1 = acc[1][bj][m][1];
#pragma unroll
                            for (int j = 0; j < 4; ++j) { o[j] = (a0[j] * gc[j] + b0[j] * ga[j]) * (1.0f / 255.0f); o[4 + j] = (a1[j] * gc[4 + j] + b1[j] * ga[4 + j]) * (1.0f / 255.0f); }
                        } else {
#pragma unroll
                            for (int j = 0; j < 4; ++j) { o[j] = a0[j] * (fmaxf(ga[j], 0.5f) * (1.0f / 255.0f)); o[4 + j] = a1[j] * (fmaxf(ga[4 + j], 0.5f) * (1.0f / 255.0f)); }
                        }
                        u32x4 w; w.x = pk2(o[0], o[1]); w.y = pk2(o[2], o[3]); w.z = pk2(o[4], o[5]); w.w = pk2(o[6], o[7]);
                        *(u32x4*)(MG + off) = w;
                    }
                }
            }
        } else {
            bf16_t* T = (bf16_t*)(ws + WS_T); const bf16_t* HBp = (const bf16_t*)(ws + WS_HB); const bool fin = (mode == MODE_OUT);
#pragma unroll
            for (int ai = 0; ai < 2; ++ai) {
                if (qsel >= 0 && ai != 0) continue;
                u32x4 tt[4][2], hh[4][2];
                if (fin) {
#pragma unroll
                    for (int m = 0; m < 4; ++m) {
                        if (qsel >= 0 && m >= mlim) continue;
#pragma unroll
                        for (int bj = 0; bj < 2; ++bj) { const size_t off = (size_t)(row0 + ai * HALF + m * 16) * D + u.pn * BM + bj * HALF + cl; tt[m][bj] = *(const u32x4*)(T + off); hh[m][bj] = *(const u32x4*)(HBp + off); }
                    }
                }
#pragma unroll
                for (int m = 0; m < 4; ++m) {
                    QSKIP(ai, m);
                    const int row = row0 + ai * HALF + m * 16; const float r = rsf(row);
#pragma unroll
                    for (int bj = 0; bj < 2; ++bj) {
                        const size_t off = (size_t)row * D + u.pn * BM + bj * HALF + cl;
                        f32x4 v0 = acc[ai][bj][m][0], v1 = acc[ai][bj][m][1];
                        if (fin) {
                            const u32x4 t = tt[m][bj], hb = hh[m][bj]; const f32x4 h0 = {bflo(hb.x), bfhi(hb.x), bflo(hb.y), bfhi(hb.y)}, h1 = {bflo(hb.z), bfhi(hb.z), bflo(hb.w), bfhi(hb.w)};
                            const f32x4 t0 = {bflo(t.x), bfhi(t.x), bflo(t.y), bfhi(t.y)}, t1 = {bflo(t.z), bfhi(t.z), bflo(t.w), bfhi(t.w)};
#pragma unroll
                            for (int j = 0; j < 4; ++j) { v0[j] = h0[j] + t0[j] * sigmoidf_(v0[j] * r); v1[j] = h1[j] + t1[j] * sigmoidf_(v1[j] * r); }
                            *(f32x4*)(dout + off) = v0; *(f32x4*)(dout + off + 4) = v1;
                        } else { u32x4 w; w.x = pk2(v0[0], v0[1]); w.y = pk2(v0[2], v0[3]); w.z = pk2(v1[0], v1[1]); w.w = pk2(v1[2], v1[3]); *(u32x4*)(T + off) = w; }
                    }
                }
            }
        }
    }
#undef QSKIP
    __device__ __forceinline__ void mid(f32x4 (&acc)[2][2][4][2], const Unit& u, int wr, int wc, int fr, int fq) const {
        asm volatile("" : "+v"(fr), "+v"(fq));
        const unsigned char* SGC = (const unsigned char*)(ws + WS_SGC); const unsigned char* SGA = (const unsigned char*)(ws + WS_SGA);
        const int row0 = u.pm * BM + wr * 64 + fr, cl = wc * 32 + 8 * fq;
        u32x2 cc[2][4][2], ss[2][4][2];
#pragma unroll
        for (int ai = 0; ai < 2; ++ai)
#pragma unroll
            for (int m = 0; m < 4; ++m)
#pragma unroll
                for (int bj = 0; bj < 2; ++bj) { const size_t off = (size_t)(row0 + ai * HALF + m * 16) * D + u.pn * BM + bj * HALF + cl; cc[ai][m][bj] = *(const u32x2*)(SGC + off); ss[ai][m][bj] = *(const u32x2*)(SGA + off); }
#pragma unroll
        for (int ai = 0; ai < 2; ++ai)
#pragma unroll
            for (int m = 0; m < 4; ++m)
#pragma unroll
                for (int bj = 0; bj < 2; ++bj) {
                    float gc[8], ga[8]; u8x8(cc[ai][m][bj], gc); u8x8(ss[ai][m][bj], ga);
#pragma unroll
                    for (int j = 0; j < 4; ++j) { acc[ai][bj][m][0][j] *= gc[j] * __builtin_amdgcn_rcpf(fmaxf(ga[j], 0.5f)); acc[ai][bj][m][1][j] *= gc[4 + j] * __builtin_amdgcn_rcpf(fmaxf(ga[4 + j], 0.5f)); }
                }
    }
};

template <class Epi, class Sched, bool ALIGN_EPI = false, bool SP2 = false>
__device__ __forceinline__ void gemm_phase(PG8_LAS unsigned char* lds, const Gemm g, const Sched& S, const Epi& E) {
    const int tid = threadIdx.x, wid = __builtin_amdgcn_readfirstlane(tid >> 6), lane = tid & 63, wr = wid >> 2, wc = wid & 3, fr = lane & 15, fq = lane >> 4;
    const int K = g.K;
    unsigned voffA[2], voffB[2];
#pragma unroll
    for (int i = 0; i < 2; ++i) { int R, C; stage_rc(tid * 16 + i * 8192, R, C); const int Rb = Epi::PERM ? ((R & ~31) + perm32(R & 31)) : R;
        voffA[i] = (unsigned)(R * K + C) * 2u; voffB[i] = (unsigned)(Rb * K + C) * 2u; }
    const size_t kstep = (size_t)(BK * 2);
    const size_t hstep = (size_t)HALF * K * 2;
    const size_t tstep = 2 * hstep;
    const unsigned ldsw = (unsigned)wid * 1024u;
    const int aoff = lds_byte(wr * 64 + fr, fq * 8), boff = lds_byte(wc * 32 + fr, fq * 8);
#define PG8_SA(b, h) (((b) * 2 + (h)) * HTB)
#define PG8_SB(b, h) ((4 + (b) * 2 + (h)) * HTB)
#define PG8_STAGE(bufoff, gbase, voff) do { _Pragma("unroll") for (int _i = 0; _i < 2; ++_i) \
        __builtin_amdgcn_global_load_lds((const unsigned*)((const char*)(gbase) + (voff)[_i]), (PG8_LAS unsigned*)(lds + (bufoff) + ldsw + _i * 8192), 16, 0, 0); } while (0)
#define PG8_LDA(dst, b, h) do { _Pragma("unroll") for (int m = 0; m < 4; ++m) _Pragma("unroll") for (int k = 0; k < 2; ++k) dst[m][k] = *(const PG8_LAS bf16x8*)(lds + PG8_SA(b, h) + aoff + m * 2048 + k * 1024); } while (0)
#define PG8_LDB(dst, b, h) do { _Pragma("unroll") for (int n = 0; n < 2; ++n) _Pragma("unroll") for (int k = 0; k < 2; ++k) dst[n][k] = *(const PG8_LAS bf16x8*)(lds + PG8_SB(b, h) + boff + n * 2048 + k * 1024); } while (0)
#define PG8_MMA(ai, bj, At, Bt) do { __builtin_amdgcn_s_setprio(1); _Pragma("unroll") for (int m = 0; m < 4; ++m) _Pragma("unroll") for (int n = 0; n < 2; ++n) _Pragma("unroll") for (int k = 0; k < 2; ++k) \
        acc[ai][bj][m][n] = __builtin_amdgcn_mfma_f32_16x16x32_bf16(Bt[n][k], At[m][k], acc[ai][bj][m][n], 0, 0, 0); __builtin_amdgcn_s_setprio(0); } while (0)
#define PG8_WAIT_V(n) asm volatile("s_waitcnt vmcnt(" #n ")" ::: "memory")
#define PG8_WAIT_L(n) asm volatile("s_waitcnt lgkmcnt(" #n ")" ::: "memory")
#define PG8_BAR __builtin_amdgcn_s_barrier()
#define PG8_SCHED __builtin_amdgcn_sched_barrier(0)
    Unit cur, nxt; int ui = 0;
    if (!S.next(0, cur)) return;
    f32x4 acc[2][2][4][2];
#pragma unroll
    for (int a = 0; a < 2; ++a)
#pragma unroll
        for (int b = 0; b < 2; ++b)
#pragma unroll
            for (int m = 0; m < 4; ++m)
#pragma unroll
                for (int n = 0; n < 2; ++n) acc[a][b][m][n] = (f32x4){0.f, 0.f, 0.f, 0.f};
    bf16x8 At[4][2], B0[2][2], B1[2][2];
    const char* cA = (const char*)g.A + (size_t)cur.pm * tstep + (size_t)cur.kt0 * kstep; const char* cB = (const char*)g.Bt + (size_t)cur.pn * tstep + (size_t)cur.kt0 * kstep;
    S.a_ready(cur);
    if constexpr (SP2) {
        PG8_STAGE(PG8_SB(0, 0), cB, voffB); PG8_STAGE(PG8_SB(0, 1), cB + hstep, voffB); PG8_STAGE(PG8_SA(0, 0), cA, voffA); PG8_STAGE(PG8_SA(0, 1), cA + hstep, voffA);
        if (wr == 1) PG8_BAR;
        PG8_WAIT_V(2); PG8_BAR;
        PG8_STAGE(PG8_SB(1, 0), cB + kstep, voffB); PG8_STAGE(PG8_SA(1, 0), cA + kstep, voffA); PG8_STAGE(PG8_SB(1, 1), cB + hstep + kstep, voffB);
        PG8_WAIT_V(6); PG8_BAR;
    } else {
        PG8_STAGE(PG8_SB(0, 0), cB, voffB); PG8_STAGE(PG8_SA(0, 0), cA, voffA); PG8_STAGE(PG8_SB(0, 1), cB + hstep, voffB); PG8_STAGE(PG8_SA(0, 1), cA + hstep, voffA);
        if (wr == 1) PG8_BAR;
        PG8_WAIT_V(4); PG8_BAR;
        PG8_STAGE(PG8_SB(1, 0), cB + kstep, voffB); PG8_STAGE(PG8_SA(1, 0), cA + kstep, voffA); PG8_STAGE(PG8_SB(1, 1), cB + hstep + kstep, voffB);
        PG8_WAIT_V(6); PG8_BAR;
    }
    for (;;) {
        const bool has_next = S.next(ui + 1, nxt);
        const char* nA = has_next ? (const char*)g.A + (size_t)nxt.pm * tstep + (size_t)nxt.kt0 * kstep : cA; const char* nB = has_next ? (const char*)g.Bt + (size_t)nxt.pn * tstep + (size_t)nxt.kt0 * kstep : cB;
        const int nt = cur.nt;
        for (int t = 0; t < nt; t += 2) {
            const bool last = (t == nt - 2);
            const char* a1 = cA + (size_t)(t + 1) * kstep;
            const char* a2 = last ? nA : cA + (size_t)(t + 2) * kstep; const char* b2 = last ? nB : cB + (size_t)(t + 2) * kstep;
            const char* a3 = a2 + kstep; const char* b3 = b2 + kstep;
            if (last && has_next) S.a_ready(nxt);
            if (E.mode == MODE_MG2 && cur.sp < 0 && t == (nt >> 1)) E.mid(acc, cur, wr, wc, fr, fq);
            if constexpr (SP2) {
            PG8_LDB(B0, 0, 0); PG8_LDB(B1, 0, 1); PG8_SCHED; PG8_LDA(At, 0, 0); PG8_STAGE(PG8_SA(1, 1), a1 + hstep, voffA);
            PG8_WAIT_V(8); PG8_WAIT_L(0); PG8_BAR; PG8_MMA(0, 0, At, B0); PG8_MMA(0, 1, At, B1); PG8_BAR; PG8_SCHED;
            PG8_LDA(At, 0, 1); PG8_STAGE(PG8_SB(0, 0), b2, voffB); PG8_STAGE(PG8_SB(0, 1), b2 + hstep, voffB); PG8_STAGE(PG8_SA(0, 0), a2, voffA);
            PG8_WAIT_V(8); PG8_WAIT_L(0); PG8_BAR; PG8_MMA(1, 0, At, B0); PG8_MMA(1, 1, At, B1); PG8_BAR; PG8_SCHED;
            PG8_LDB(B0, 1, 0); PG8_LDB(B1, 1, 1); PG8_SCHED; PG8_LDA(At, 1, 0); PG8_STAGE(PG8_SA(0, 1), a2 + hstep, voffA);
            PG8_WAIT_V(8); PG8_WAIT_L(0); PG8_BAR; PG8_MMA(0, 0, At, B0); PG8_MMA(0, 1, At, B1); PG8_BAR; PG8_SCHED;
            PG8_LDA(At, 1, 1); PG8_STAGE(PG8_SB(1, 0), b3, voffB); PG8_STAGE(PG8_SB(1, 1), b3 + hstep, voffB); PG8_STAGE(PG8_SA(1, 0), a3, voffA);
            PG8_WAIT_V(8); PG8_WAIT_L(0); PG8_BAR; PG8_MMA(1, 0, At, B0); PG8_MMA(1, 1, At, B1); PG8_BAR; PG8_SCHED;
            } else {
            PG8_LDB(B0, 0, 0); PG8_SCHED; PG8_LDA(At, 0, 0); PG8_STAGE(PG8_SA(1, 1), a1 + hstep, voffA);
            PG8_WAIT_L(8); PG8_BAR; PG8_WAIT_L(0); PG8_MMA(0, 0, At, B0); PG8_BAR; PG8_SCHED;
            PG8_LDB(B1, 0, 1); PG8_STAGE(PG8_SB(0, 0), b2, voffB);
            PG8_BAR; PG8_WAIT_L(0); PG8_MMA(0, 1, At, B1); PG8_BAR;
            PG8_LDA(At, 0, 1); PG8_STAGE(PG8_SA(0, 0), a2, voffA);
            PG8_BAR; PG8_WAIT_L(0); PG8_MMA(1, 0, At, B0); PG8_BAR; PG8_SCHED;
            PG8_STAGE(PG8_SB(0, 1), b2 + hstep, voffB);
            PG8_WAIT_V(6); PG8_BAR; PG8_MMA(1, 1, At, B1); PG8_BAR;
            PG8_LDB(B0, 1, 0); PG8_SCHED; PG8_LDA(At, 1, 0); PG8_STAGE(PG8_SA(0, 1), a2 + hstep, voffA);
            PG8_WAIT_L(8); PG8_BAR; PG8_WAIT_L(0); PG8_MMA(0, 0, At, B0); PG8_BAR; PG8_SCHED;
            PG8_LDB(B1, 1, 1); PG8_STAGE(PG8_SB(1, 0), b3, voffB);
            PG8_BAR; PG8_WAIT_L(0); PG8_MMA(0, 1, At, B1); PG8_BAR;
            PG8_LDA(At, 1, 1); PG8_STAGE(PG8_SA(1, 0), a3, voffA);
            PG8_BAR; PG8_WAIT_L(0); PG8_MMA(1, 0, At, B0); PG8_BAR; PG8_SCHED;
            PG8_STAGE(PG8_SB(1, 1), b3 + hstep, voffB);
            PG8_WAIT_V(6); PG8_BAR; PG8_MMA(1, 1, At, B1); PG8_BAR;
            }
        }
        if constexpr (ALIGN_EPI) { if (wr == 0) PG8_BAR; }
        if constexpr (!Epi::AFTER_DRAIN) { E(acc, cur, wr, wc, fr, fq); S.done(cur); }
        if (!has_next) break;
#pragma unroll
        for (int a = 0; a < 2; ++a)
#pragma unroll
            for (int b = 0; b < 2; ++b)
#pragma unroll
                for (int m = 0; m < 4; ++m)
#pragma unroll
                    for (int n = 0; n < 2; ++n) acc[a][b][m][n] = (f32x4){0.f, 0.f, 0.f, 0.f};
        cur = nxt; cA = nA; cB = nB; ++ui;
        if constexpr (ALIGN_EPI) { if (wr == 1) PG8_BAR; }
    }
    PG8_WAIT_V(0);
    if constexpr (!ALIGN_EPI) { if (wr == 0) PG8_BAR; }
    PG8_BAR;
    if constexpr (Epi::AFTER_DRAIN) { E.fused(acc, cur, wr, wc, fr, fq, lds, wid, lane); S.done(cur); }
#undef PG8_SA
#undef PG8_SB
#undef PG8_STAGE
#undef PG8_LDA
#undef PG8_LDB
#undef PG8_MMA
#undef PG8_WAIT_V
#undef PG8_WAIT_L
#undef PG8_BAR
#undef PG8_SCHED
}}

struct Args { const float* in[28]; float* out; unsigned char* ws; int lo, hi; };
enum { I_XP = 0, I_XS, I_PP, I_PS, I_SCONV, I_CK, I_CV, I_REL, I_F1N, I_F1G, I_F1U, I_F1D, I_MIXN, I_WIN, I_CONVW, I_QN, I_KN, I_SINK, I_WCO, I_WAO, I_WOUT, I_F2N, I_F2G, I_F2U, I_F2D, I_PLEN, I_WPLE, I_WPG };
constexpr int NWAVES = 8, NTHR = 512;
#define RLX_AGENT __ATOMIC_RELAXED, __HIP_MEMORY_SCOPE_AGENT
constexpr int RING_BYTES = 131072, MISC_OFF = 134144, LDS_BYTES = 135168;

__device__ __forceinline__ void tr_item(const float* src, int srcN, int colA, int colB, const float* gain, int K, bf16_t* dst, int drow0, int k0, LAS float* scr, int lane, int kd0 = -1) {
    if (kd0 < 0) kd0 = k0;
    const float* sp = src + (size_t)k0 * srcN + ((lane < 32) ? colA + lane : colB + lane - 32);
    const float g = gain ? gain[k0 + lane] : 1.0f;
    float v[64];
#pragma unroll
    for (int kk = 0; kk < 64; ++kk) v[kk] = sp[(size_t)kk * srcN];
#pragma unroll
    for (int kk = 0; kk < 64; ++kk) scr[kk * 65 + lane] = v[kk] * __builtin_bit_cast(float, __builtin_amdgcn_readlane(__builtin_bit_cast(int, g), kk));
    asm volatile("s_waitcnt lgkmcnt(0)" ::: "memory");
    const int c = lane & 7;
#pragma unroll
    for (int j = 0; j < 8; ++j) { const int n = (lane >> 3) + 8 * j; const LAS float* s = scr + (8 * c) * 65 + n;
        u32x4 o; o.x = pk2(s[0 * 65], s[1 * 65]); o.y = pk2(s[2 * 65], s[3 * 65]); o.z = pk2(s[4 * 65], s[5 * 65]); o.w = pk2(s[6 * 65], s[7 * 65]);
        *(u32x4*)(dst + (size_t)(drow0 + n) * K + kd0 + 8 * c) = o; }
    asm volatile("s_waitcnt lgkmcnt(0)" ::: "memory");
}
__device__ __forceinline__ float wave_sum(float v) {
#pragma unroll
    for (int o = 1; o < 64; o <<= 1) v += __shfl_xor(v, o);
    return v;
}
__device__ __forceinline__ int win_col(int n0) {
    const int pn = n0 >> 8, r = n0 & 255;
    if (pn < 4) return n0;
    if (pn < 12) return ((r >> 7) ? 2048 : 1024) + 128 * (pn - 4) + (r & 127);
    if (pn < 16) return 3072 + 64 * (4 * (pn - 12) + ((r >> 5) & 3)) + 32 * (r >> 7);
    if (pn == 16) return 4096 + 64 * ((r >> 5) & 3) + 32 * (r >> 7);
    if (pn == 17) return 4352 + r;
    if (pn < 26) return 4608 + 256 * (pn - 18) + r;
    return 6656 + 256 * (pn - 26) + r;
}
enum { J_W1 = 0, J_W1D, J_WIN, J_WCO, J_WAO, J_WOUT, J_W2, J_W2D, J_WPLE, J_WPG };
__device__ __forceinline__ int job_items(int j) { return j == J_W1 || j == J_W2 ? 32 * 128 : j == J_W1D || j == J_W2D ? 64 * 32 : j == J_WIN ? 32 * 136 : j == J_WCO || j == J_WAO ? 16 * 32 : j == J_WPLE ? 4 * 32 : 32 * 32; }
__device__ __forceinline__ void job_item(const Args& a, int j, int r, LAS float* scr, int lane) {
    unsigned char* ws = a.ws;
    if (j == J_W1 || j == J_W2) { const int kb = r / 128, n0 = (r % 128) * 64; const int pn = n0 >> 8, rr = n0 & 255, c0 = 128 * pn + (rr & 127); const bool f2 = (j == J_W2);
        tr_item((rr >> 7) ? a.in[f2 ? I_F2U : I_F1U] : a.in[f2 ? I_F2G : I_F1G], FF, c0, c0 + 32, a.in[f2 ? I_F2N : I_F1N], D, (bf16_t*)(ws + (f2 ? WS_W2 : WS_W1)), n0, kb * 64, scr, lane); }
    else if (j == J_WIN) { const int kb = r / 136, n0 = (r % 136) * 64; tr_item(a.in[I_WIN], NIN, win_col(n0), win_col(n0 + 32), a.in[I_MIXN], D, (bf16_t*)(ws + WS_WIN), n0, kb * 64, scr, lane); }
    else { const int kb = r / 32, n0 = (r % 32) * 64;
        const float* src; const float* gain = nullptr; int K; size_t dst; int kd = kb * 64;
        if (j == J_W1D) { src = a.in[I_F1D]; K = FF; dst = WS_W1D; } else if (j == J_W2D) { src = a.in[I_F2D]; K = FF; dst = WS_W2D; }
        else if (j == J_WCO) { src = a.in[I_WCO]; K = MIXP; dst = WS_WCO; } else if (j == J_WAO) { src = a.in[I_WAO]; K = MIXP; dst = WS_WCO; kd += DC; }
        else if (j == J_WOUT) { src = a.in[I_WOUT]; K = D; dst = WS_WOUT; } else if (j == J_WPLE) { src = a.in[I_WPLE]; K = DPLE; dst = WS_WPLE; }
        else { src = a.in[I_WPG]; K = D; dst = WS_WPG; gain = a.in[I_PLEN]; }
        tr_item(src, D, n0, n0 + 32, gain, K, (bf16_t*)(ws + dst), n0, kb * 64, scr, lane, kd); }
}
__device__ __forceinline__ void convert_jobs(const Args& a, int j0, int j1, int w, int nw, LAS unsigned char* lds, int wave, int lane) {
    LAS float* scr = (LAS float*)(lds + wave * 16640);
    int base = 0;
    for (int j = j0; j < j1; ++j) { const int ni = job_items(j);
        for (int it = (w + nw - (base % nw)) % nw; it < ni; it += nw) job_item(a, j, it, scr, lane);
        base += ni; }
}
__device__ __forceinline__ void prologue(const Args& a, LAS unsigned char* lds, int gw, int NGW, int wave, int lane) {
    unsigned char* ws = a.ws;
    if (NGW == 256 * NWAVES) {
        convert_jobs(a, J_W1, J_W1 + 1, gw, NGW, lds, wave, lane);
        convert_jobs(a, J_WPLE, J_WPG + 1, gw, NGW, lds, wave, lane);
    } else convert_jobs(a, J_W1, J_WPG + 1, gw, NGW, lds, wave, lane);
    auto xrow = [&](int m) -> const float* { return (m < MP) ? a.in[I_XP] + (size_t)m * D : a.in[I_XS] + (size_t)(m - MP) * D; };
    auto prow = [&](int m) -> const float* { return (m < MP) ? a.in[I_PP] + (size_t)m * DPLE : a.in[I_PS] + (size_t)(m - MP) * DPLE; };
    auto finish = [&](int m, const f32x4 (&v)[8], const f32x4& p) {
        float s = 0.f;
#pragma unroll
        for (int j = 0; j < 8; ++j) s += (v[j][0] * v[j][0] + v[j][1] * v[j][1]) + (v[j][2] * v[j][2] + v[j][3] * v[j][3]);
        const float ms = wave_sum(s) * (1.0f / D) + EPS; const float rstd = rsqrtf(ms);
        if (lane == 0) ((float*)(ws + WS_RMS0))[m] = sqrtf(ms);
        u32x2* o = (u32x2*)((bf16_t*)(ws + WS_XN) + (size_t)m * D);
#pragma unroll
        for (int j = 0; j < 8; ++j) { u32x2 w; w.x = pk2(v[j][0] * rstd, v[j][1] * rstd); w.y = pk2(v[j][2] * rstd, v[j][3] * rstd); o[lane + 64 * j] = w; }
        u32x2 w; w.x = pk2(p[0], p[1]); w.y = pk2(p[2], p[3]);
        ((u32x2*)((bf16_t*)(ws + WS_PE) + (size_t)m * DPLE))[lane] = w;
    };
    for (int m = gw; m < M; m += 2 * NGW) {
        const int m2 = m + NGW; const bool two = m2 < M;
        f32x4 v1[8], v2[8], p1, p2;
        const float* x1 = xrow(m); const float* x2 = xrow(two ? m2 : m);
#pragma unroll
        for (int j = 0; j < 8; ++j) v1[j] = ((const f32x4*)x1)[lane + 64 * j];
#pragma unroll
        for (int j = 0; j < 8; ++j) v2[j] = ((const f32x4*)x2)[lane + 64 * j];
        p1 = ((const f32x4*)prow(m))[lane]; p2 = ((const f32x4*)prow(two ? m2 : m))[lane];
        finish(m, v1, p1);
        if (two) finish(m2, v2, p2);
    }
}

constexpr int KS_STRIDE = 144, VT_STRIDE = 400, ATT_KS = 0, ATT_VT = 28672, ATT_LUT = 55296;
__device__ __forceinline__ int t5_bucket(int rel) {
    const int n = rel < 0 ? -rel : rel; int b = rel > 0 ? 16 : 0;
    if (n < 8) return b + n;
    int lg = 8 + (31 - __builtin_clz((unsigned)(n * n))) - 6; if (lg > 15) lg = 15;
    return b + lg;
}
__device__ __forceinline__ void attn_conv_phase(const Args& a, LAS unsigned char* lds) {
    int tid = threadIdx.x; asm volatile("" : "+v"(tid));
    const int lane = tid & 63, wave = __builtin_amdgcn_readfirstlane(tid >> 6);
    unsigned char* ws = a.ws;
    const bf16_t* Qb = (const bf16_t*)(ws + WS_Q); bf16_t* Ob = (bf16_t*)(ws + WS_O); const bf16_t* Kb = (const bf16_t*)(ws + WS_K); const bf16_t* Vb = (const bf16_t*)(ws + WS_V);
    LAS bf16_t* Ks = (LAS bf16_t*)(lds + ATT_KS); LAS bf16_t* Vt = (LAS bf16_t*)(lds + ATT_VT); LAS float* lut = (LAS float*)(lds + ATT_LUT);
    const int g = wave >> 1, qh = wave & 1, q = lane & 31, h = lane >> 5;
    for (int uid = blockIdx.x; uid < 1024 + 64; uid += gridDim.x) {
        const bool smp = uid >= 1024; int b, c, kvh;
        if (!smp) { kvh = uid & 3; c = (uid >> 2) & 127; b = uid >> 9; } else { const int s = uid - 1024; kvh = s & 3; b = s >> 2; c = 0; }
        auto ldrow = [&](bool isv, int j, int ck) -> u32x4 {
            u32x4 w = {0u, 0u, 0u, 0u};
            if (!smp) { const int pos = 64 * (c - 2) + j; if (pos >= 0) w = *(const u32x4*)((isv ? Vb : Kb) + (size_t)(b * SEQ + pos) * 256 + kvh * 64 + 8 * ck); }
            else if (j < 128) { const float* cp = a.in[isv ? I_CV : I_CK] + ((size_t)(b * 128 + j) * 4 + kvh) * 64 + 8 * ck; const f32x4 x0 = *(const f32x4*)cp, x1 = *(const f32x4*)(cp + 4);
                w.x = pk2(x0[0], x0[1]); w.y = pk2(x0[2], x0[3]); w.z = pk2(x1[0], x1[1]); w.w = pk2(x1[2], x1[3]); }
            else if (j < 144) w = *(const u32x4*)((isv ? Vb : Kb) + (size_t)(MP + b * 16 + (j - 128)) * 256 + kvh * 64 + 8 * ck);
            return w; };
        u32x4 kw[3], vw[4];
#pragma unroll
        for (int i = 0; i < 3; ++i) { const int idx = tid + i * NTHR; kw[i] = ldrow(false, idx >> 3, idx & 7); }
        const int vjg = tid >> 3, vck = tid & 7;
        if (tid < 384) {
#pragma unroll
            for (int i = 0; i < 4; ++i) vw[i] = ldrow(true, 4 * vjg + i, vck); }
#pragma unroll
        for (int i = 0; i < 3; ++i) { const int idx = tid + i * NTHR; *(LAS u32x4*)((LAS unsigned char*)Ks + (idx >> 3) * KS_STRIDE + (idx & 7) * 16) = kw[i]; }
        if (tid < 384) {
            LAS unsigned char* vp = (LAS unsigned char*)Vt + (8 * vck) * VT_STRIDE + 8 * vjg;
#pragma unroll
            for (int e = 0; e < 4; ++e) {
                const unsigned w0 = e == 0 ? vw[0].x : e == 1 ? vw[0].y : e == 2 ? vw[0].z : vw[0].w, w1 = e == 0 ? vw[1].x : e == 1 ? vw[1].y : e == 2 ? vw[1].z : vw[1].w;
                const unsigned w2 = e == 0 ? vw[2].x : e == 1 ? vw[2].y : e == 2 ? vw[2].z : vw[2].w, w3 = e == 0 ? vw[3].x : e == 1 ? vw[3].y : e == 2 ? vw[3].z : vw[3].w;
                u32x2 lo, hi; lo.x = (w0 & 0xffffu) | (w1 << 16); lo.y = (w2 & 0xffffu) | (w3 << 16); hi.x = (w0 >> 16) | (w1 & 0xffff0000u); hi.y = (w2 >> 16) | (w3 & 0xffff0000u);
                *(LAS u32x2*)(vp + (2 * e) * VT_STRIDE) = lo; *(LAS u32x2*)(vp + (2 * e + 1) * VT_STRIDE) = hi;
            }
        }
        for (int idx = tid; idx < 1024; idx += NTHR) { const int gg = idx >> 8, r = idx & 255; lut[idx] = a.in[I_REL][t5_bucket(r - 191) * 16 + 4 * kvh + gg] * 1.44269504f; }
        const int iq = smp ? (q & 15) : 32 * qh + q;
        const size_t qrow = smp ? (size_t)(MP + b * 16 + iq) : (size_t)(b * SEQ + 64 * c + iq);
        const bf16_t* qp = Qb + qrow * 1024 + (4 * kvh + g) * 64; bf16_t* op = Ob + qrow * MIXP + (4 * kvh + g) * 64;
        bf16x8 qf[4];
#pragma unroll
        for (int s = 0; s < 4; ++s) qf[s] = *(const bf16x8*)(qp + 16 * s + 8 * h);
        const float sink = a.in[I_SINK][4 * kvh + g] * 1.44269504f;
        __syncthreads();
        if (!(smp && qh)) {
            f32x16 st[6];
#pragma unroll
            for (int kt = 0; kt < 6; ++kt) {
#pragma unroll
                for (int i = 0; i < 16; ++i) st[kt][i] = 0.f;
#pragma unroll
                for (int s = 0; s < 4; ++s) {
                    const bf16x8 kf = *(const LAS bf16x8*)((const LAS unsigned char*)Ks + (32 * kt + q) * KS_STRIDE + (16 * s + 8 * h) * 2);
                    st[kt] = __builtin_amdgcn_mfma_f32_32x32x16_bf16(kf, qf[s], st[kt], 0, 0, 0);
                }
            }
            const int kmin = smp ? 0 : (c >= 2 ? 0 : 128 - 64 * c), kmax = smp ? 144 : 192; const bool need_mask = smp || c < 2;
#pragma unroll
            for (int kt = 0; kt < 6; ++kt)
#pragma unroll
                for (int i = 0; i < 16; ++i) { const int key = 32 * kt + 8 * (i >> 2) + 4 * h + (i & 3); st[kt][i] = st[kt][i] * (0.125f * 1.44269504f) + lut[g * 256 + key - iq + 63]; }
            if (need_mask) {
#pragma unroll
                for (int kt = 0; kt < 6; ++kt)
#pragma unroll
                    for (int i = 0; i < 16; ++i) { const int key = 32 * kt + 8 * (i >> 2) + 4 * h + (i & 3); if (key < kmin || key >= kmax) st[kt][i] = -1e30f; }
            }
            float mx = -3.0e38f;
#pragma unroll
            for (int kt = 0; kt < 6; ++kt)
#pragma unroll
                for (int i = 0; i < 16; ++i) mx = fmaxf(mx, st[kt][i]);
            mx = fmaxf(mx, __shfl_xor(mx, 32)); mx = fmaxf(mx, sink);
            float l = 0.f;
#pragma unroll
            for (int kt = 0; kt < 6; ++kt)
#pragma unroll
                for (int i = 0; i < 16; ++i) { const float e = __builtin_amdgcn_exp2f(st[kt][i] - mx); st[kt][i] = e; l += e; }
            l += __shfl_xor(l, 32); l += __builtin_amdgcn_exp2f(sink - mx);
            f32x16 ot[2];
#pragma unroll
            for (int i = 0; i < 16; ++i) { ot[0][i] = 0.f; ot[1][i] = 0.f; }
#pragma unroll
            for (int kt = 0; kt < 6; ++kt)
#pragma unroll
                for (int s = 0; s < 2; ++s) {
                    u32x4 pw; pw.x = pk2(st[kt][8 * s + 0], st[kt][8 * s + 1]); pw.y = pk2(st[kt][8 * s + 2], st[kt][8 * s + 3]); pw.z = pk2(st[kt][8 * s + 4], st[kt][8 * s + 5]); pw.w = pk2(st[kt][8 * s + 6], st[kt][8 * s + 7]);
                    const bf16x8 pf = __builtin_bit_cast(bf16x8, pw);
#pragma unroll
                    for (int dt = 0; dt < 2; ++dt) {
                        const LAS unsigned char* vp = (const LAS unsigned char*)Vt + (32 * dt + q) * VT_STRIDE + (32 * kt + 16 * s + 4 * h) * 2;
                        const s16x4 lo = *(const LAS s16x4*)vp, hi = *(const LAS s16x4*)(vp + 16);
                        const bf16x8 vf = {lo[0], lo[1], lo[2], lo[3], hi[0], hi[1], hi[2], hi[3]};
                        ot[dt] = __builtin_amdgcn_mfma_f32_32x32x16_bf16(vf, pf, ot[dt], 0, 0, 0);
                    }
                }
            const float inv = 1.0f / l;
            if (!smp || q < 16) {
#pragma unroll
                for (int dt = 0; dt < 2; ++dt)
#pragma unroll
                    for (int k = 0; k < 2; ++k) {
                        u32x2 g0, g1;
                        g0.x = pk2(ot[dt][8 * k + 0] * inv, ot[dt][8 * k + 1] * inv); g0.y = pk2(ot[dt][8 * k + 2] * inv, ot[dt][8 * k + 3] * inv);
                        g1.x = pk2(ot[dt][8 * k + 4] * inv, ot[dt][8 * k + 5] * inv); g1.y = pk2(ot[dt][8 * k + 6] * inv, ot[dt][8 * k + 7] * inv);
                        const unsigned sx = h ? g0.x : g1.x, sy = h ? g0.y : g1.y;
                        const unsigned rx = (unsigned)__shfl_xor((int)sx, 32), ry = (unsigned)__shfl_xor((int)sy, 32);
                        u32x4 w; if (h) { w.x = rx; w.y = ry; w.z = g1.x; w.w = g1.y; } else { w.x = g0.x; w.y = g0.y; w.z = rx; w.w = ry; }
                        *(u32x4*)(op + 32 * dt + 16 * k + 8 * h) = w;
                    }
            }
        }
        __syncthreads();
    }
    {
        const bf16_t* CB = (const bf16_t*)(ws + WS_CB); bf16_t* CCU = (bf16_t*)(ws + WS_CCU); const bf16_t* U = (const bf16_t*)(ws + WS_U);
        const int ch = (tid & 127) * 8;
        float w0[8], w1[8], w2[8];
#pragma unroll
        for (int e = 0; e < 8; ++e) { w0[e] = a.in[I_CONVW][ch + e]; w1[e] = a.in[I_CONVW][DC + ch + e]; w2[e] = a.in[I_CONVW][2 * DC + ch + e]; }
        int rbeg, rend;
        if (gridDim.x == 256) { const int cc = blockIdx.x; if (cc < 64) { rbeg = cc * 44; rend = rbeg + 44; } else { rbeg = 64 * 44 + (cc - 64) * 72; rend = rbeg + 72; } }
        else { const int per = (M + gridDim.x - 1) / gridDim.x; rbeg = blockIdx.x * per; rend = rbeg + per < M ? rbeg + per : M; }
#pragma unroll 2
        for (int row = rbeg + (tid >> 7); row < rend; row += 4) {
            int t, bb; const bool smp = row >= MP;
            if (!smp) { t = row & (SEQ - 1); bb = row >> 13; } else { t = row & 15; bb = (row - MP) >> 4; }
            const u32x4 cb = *(const u32x4*)(CB + (size_t)row * DC + ch), u0 = *(const u32x4*)(U + (size_t)row * DC + ch);
            float p1[8], p2[8];
            if (t >= 1) { const u32x4 x = *(const u32x4*)(U + (size_t)(row - 1) * DC + ch); p1[0] = bflo(x.x); p1[1] = bfhi(x.x); p1[2] = bflo(x.y); p1[3] = bfhi(x.y); p1[4] = bflo(x.z); p1[5] = bfhi(x.z); p1[6] = bflo(x.w); p1[7] = bfhi(x.w); }
            else if (smp) { const float* sp = a.in[I_SCONV] + ((size_t)bb * 2 + 1) * DC + ch;
#pragma unroll
                for (int e = 0; e < 8; ++e) p1[e] = sp[e]; }
            else {
#pragma unroll
                for (int e = 0; e < 8; ++e) p1[e] = 0.f; }
            if (t >= 2) { const u32x4 x = *(const u32x4*)(U + (size_t)(row - 2) * DC + ch); p2[0] = bflo(x.x); p2[1] = bfhi(x.x); p2[2] = bflo(x.y); p2[3] = bfhi(x.y); p2[4] = bflo(x.z); p2[5] = bfhi(x.z); p2[6] = bflo(x.w); p2[7] = bfhi(x.w); }
            else if (smp) { const float* sp = a.in[I_SCONV] + ((size_t)bb * 2 + t) * DC + ch;
#pragma unroll
                for (int e = 0; e < 8; ++e) p2[e] = sp[e]; }
            else {
#pragma unroll
                for (int e = 0; e < 8; ++e) p2[e] = 0.f; }
            float uc[8] = {bflo(u0.x), bfhi(u0.x), bflo(u0.y), bfhi(u0.y), bflo(u0.z), bfhi(u0.z), bflo(u0.w), bfhi(u0.w)};
            float cf[8] = {bflo(cb.x), bfhi(cb.x), bflo(cb.y), bfhi(cb.y), bflo(cb.z), bfhi(cb.z), bflo(cb.w), bfhi(cb.w)};
            float o[8];
#pragma unroll
            for (int e = 0; e < 8; ++e) o[e] = cf[e] * (w0[e] * p2[e] + w1[e] * p1[e] + w2[e] * uc[e]);
            u32x4 w; w.x = pk2(o[0], o[1]); w.y = pk2(o[2], o[3]); w.z = pk2(o[4], o[5]); w.w = pk2(o[6], o[7]);
            *(u32x4*)(CCU + (size_t)row * MIXP + ch) = w;
        }
    }
}

#define XB_TMO      128
#define XB_XCNT(j)  (256  + 64 * (j))
#define XB_XSUB(j)  (1280 + 64 * (j))
#define XB_XGEN(j)  (2304 + 64 * (j))
#define XB_TOP      3328
#define XB_TOPGEN   3392
#define XCD_BAR_WORDS 3456
#define XB_SPIN_CAP (1u << 18)

__device__ __forceinline__ unsigned xb_ld(unsigned* p)              { return __hip_atomic_load(p, __ATOMIC_RELAXED, __HIP_MEMORY_SCOPE_AGENT); }
__device__ __forceinline__ unsigned xb_add(unsigned* p, unsigned v) { return __hip_atomic_fetch_add(p, v, __ATOMIC_RELAXED, __HIP_MEMORY_SCOPE_AGENT); }
__device__ __forceinline__ unsigned xb_xcc_id() { return (unsigned)__builtin_amdgcn_s_getreg((3 << 11) | 20) & 0xFu; }
#define XB_SPIN(cond, bar) do { unsigned _sp = 0; while (cond) { __builtin_amdgcn_s_sleep(1); \
    if ((++_sp & 255u) == 0u) { if (xb_ld(&(bar)[XB_TMO])) break; if (_sp > XB_SPIN_CAP) { atomicAdd(&(bar)[XB_TMO], 1u); break; } } } } while (0)

struct XcdBarrier {
    unsigned* bar; unsigned x;
    volatile LAS unsigned* st;
};

__device__ __forceinline__ XcdBarrier xcd_barrier_post(unsigned* bar, volatile LAS unsigned* st) {
    XcdBarrier b; b.bar = bar; b.x = xb_xcc_id(); b.st = st;
    if (threadIdx.x == 0) (void)xb_add(&bar[XB_XCNT(b.x)], 1u);
    return b;
}
__device__ __forceinline__ void xcd_barrier_complete(unsigned* bar, unsigned x, unsigned& nloc, unsigned& nx) {
    const unsigned G = gridDim.x * gridDim.y * gridDim.z;
    unsigned sum, cnt, mine, sp = 0u;
    for (;;) {
        sum = 0u; cnt = 0u; mine = 0u;
#pragma unroll
        for (unsigned j = 0; j < 16; ++j) { const unsigned c = xb_ld(&bar[XB_XCNT(j)]); sum += c; cnt += (c > 0u) ? 1u : 0u; mine = (j == x) ? c : mine; }
        if (sum == G) break;
        __builtin_amdgcn_s_sleep(1);
        if ((++sp & 255u) == 0u) { if (xb_ld(&bar[XB_TMO])) break; if (sp > XB_SPIN_CAP) { atomicAdd(&bar[XB_TMO], 1u); break; } }
    }
    nloc = mine > 0u ? mine : 1u; nx = cnt > 0u ? cnt : 1u;
}

__device__ __forceinline__ void xcd_barrier(const XcdBarrier& b) {
    asm volatile("s_waitcnt vmcnt(0)" ::: "memory");
    __syncthreads();
    if (threadIdx.x == 0) {
        unsigned* bar = b.bar;
        __builtin_amdgcn_s_waitcnt(0);
        unsigned nloc = b.st[0], nx = b.st[1];
        if (nloc == 0u) { xcd_barrier_complete(bar, b.x, nloc, nx); b.st[0] = nloc; b.st[1] = nx; }
        const unsigned old = xb_add(&bar[XB_XSUB(b.x)], 1u);
        const unsigned gen = old / nloc;
        if (old + 1u == (gen + 1u) * nloc) {
            __builtin_amdgcn_fence(__ATOMIC_RELEASE, "agent");
            asm volatile("s_waitcnt vmcnt(0)" ::: "memory");
            const unsigned og = xb_add(&bar[XB_TOP], 1u);
            const unsigned tg = og / nx;
            if (og + 1u == (tg + 1u) * nx) xb_add(&bar[XB_TOPGEN], 1u);
            else XB_SPIN(xb_ld(&bar[XB_TOPGEN]) == tg, bar);
            __builtin_amdgcn_fence(__ATOMIC_ACQUIRE, "agent");
            xb_add(&bar[XB_XGEN(b.x)], 1u);
            asm volatile("s_waitcnt vmcnt(0)" ::: "memory");
        } else {
            XB_SPIN(xb_ld(&bar[XB_XGEN(b.x)]) == gen, bar);
            __builtin_amdgcn_fence(__ATOMIC_ACQUIRE, "agent");
            asm volatile("s_waitcnt vmcnt(0)" ::: "memory");
        }
    }
    __syncthreads();
}

constexpr int NSTEPS = 12;
__global__ void __launch_bounds__(NTHR, 2) fwd_kernel(Args args) {
    extern __shared__ __attribute__((aligned(16))) unsigned char lds_raw[];
    LAS unsigned char* lds = (LAS unsigned char*)lds_raw;
    const int tid = threadIdx.x, lane = tid & 63, wave = __builtin_amdgcn_readfirstlane(tid >> 6);
    const int G = gridDim.x;
    unsigned char* ws = args.ws;
    volatile LAS unsigned* MISC = (volatile LAS unsigned*)(lds + MISC_OFF);
    if (tid < 64) MISC[tid] = 0u;
    __syncthreads();
    const bool one_launch = (args.hi - args.lo) > 1;
    XcdBarrier xbar; xbar.bar = (unsigned*)(ws + WS_CTL) + CW_BAR; xbar.x = 0; xbar.st = nullptr;
    if (one_launch) xbar = xcd_barrier_post((unsigned*)(ws + WS_CTL) + CW_BAR, MISC + 8);
    if (args.lo < 0) cg::this_grid().sync();
#define SEAM(step, sync_after) do { if ((step) + 1 < args.hi) { if (sync_after) xcd_barrier(xbar); else { asm volatile("s_waitcnt vmcnt(0)" ::: "memory"); __syncthreads(); } } } while (0)
    if (args.lo <= 0 && 0 < args.hi) {
        const int vcu = (G % 8 == 0) ? (blockIdx.x % 8) * (G / 8) + blockIdx.x / 8 : blockIdx.x;
        prologue(args, lds, vcu * NWAVES + wave, G * NWAVES, wave, lane);
        SEAM(0, true);
    }
    for (int step = (args.lo > 1 ? args.lo : 1); step < (args.hi < 4 ? args.hi : 4); ++step) {
        pg8::Gemm g; pg8::Epi E;
        E.ws = ws; E.dout = args.out; E.scale = 1.f; E.ssp_in_off = 0; E.ssp_out_off = 0; E.step = step; E.xp = nullptr; E.xs = nullptr; E.qn = args.in[I_QN]; E.kn = args.in[I_KN];
        g.M = M;
        if (step == 1) { g.A = (const bf16_t*)(ws + WS_XN); g.Bt = (const bf16_t*)(ws + WS_W1); g.N = 2 * FF; g.K = D; E.mode = pg8::MODE_GU; }
        else if (step == 2) { g.A = (const bf16_t*)(ws + WS_A1); g.Bt = (const bf16_t*)(ws + WS_W1D); g.N = D; g.K = FF; E.mode = pg8::MODE_RES; E.scale = 0.5f; E.xp = args.in[I_XP]; E.xs = args.in[I_XS];
                 E.ssp_out_off = (unsigned)WS_SSP1; }
        else { g.A = (const bf16_t*)(ws + WS_HB); g.Bt = (const bf16_t*)(ws + WS_WIN); g.N = NIN; g.K = D; E.mode = pg8::MODE_IN; E.ssp_in_off = (unsigned)WS_SSP1; }
        E.mypm = -1; E.rtab = (const LAS float*)(lds + RING_BYTES);
        if ((E.ssp_in_off || E.xp) && G == 256) {
            const int c_ = (int)blockIdx.x, pmq = 8 * (c_ & 7) + ((c_ >> 3) & 7); int t_ = threadIdx.x; asm volatile("" : "+v"(t_));
            if (E.xp && t_ >= 256) ((LAS float*)(lds + RING_BYTES))[t_] = ((const float*)(ws + WS_RMS0))[pmq * 256 + t_ - 256];
            if (E.ssp_in_off && t_ < 256) { const float* p_ = (const float*)(ws + E.ssp_in_off) + (size_t)(pmq * 256 + t_); float s_ = 0.f;
#pragma unroll
                for (int k_ = 0; k_ < 32; k_ += 4) s_ += (p_[(size_t)k_ * M] + p_[(size_t)(k_ + 1) * M]) + (p_[(size_t)(k_ + 2) * M] + p_[(size_t)(k_ + 3) * M]);
                ((LAS float*)(lds + RING_BYTES))[t_] = rsqrtf(s_ * (1.0f / D) + EPS); }
            __syncthreads(); E.mypm = pmq;
        }
        pg8::PhaseOrder S; const int nsplit = (step == 3) ? 1 : (g.N == D ? 8 : 4); E.S = nsplit; S.init(g.N, g.K, nsplit, G, (int)blockIdx.x);
        pg8::gemm_phase<pg8::Epi, pg8::PhaseOrder, true, true>(lds, g, S, E);
        {
            const int c = (int)blockIdx.x; int tlane = threadIdx.x; asm volatile("" : "+v"(tlane)); tlane &= 63;
            if (G != 256) {} else if (step == 1 && c >= 128) convert_jobs(args, J_W1D, J_W1D + 1, (c - 128) * NWAVES + wave, 128 * NWAVES, lds, wave, tlane);
            else if (step == 2 && c >= 64) convert_jobs(args, J_WIN, J_WIN + 1, (c - 64) * NWAVES + wave, 192 * NWAVES, lds, wave, tlane);
            else if (step == 3 && c >= 128 && c < 222) convert_jobs(args, J_WCO, J_WOUT + 1, (c - 128) * NWAVES + wave, 94 * NWAVES, lds, wave, tlane);
        }
        SEAM(step, true);
    }
    if (args.lo <= 4 && 4 < args.hi) {
        attn_conv_phase(args, lds);
        SEAM(4, true);
    }
    for (int step = (args.lo > 5 ? args.lo : 5); step < args.hi; ++step) {
        if (step == 6) continue;
        bool sync_after = true;
        pg8::Gemm g; pg8::Epi E;
        E.ws = ws; E.dout = args.out; E.scale = 1.f; E.ssp_in_off = 0; E.ssp_out_off = 0; E.step = step; E.xp = nullptr; E.xs = nullptr; E.qn = nullptr; E.kn = nullptr;
        g.M = M;
        switch (step) {
        case 5:  g.A = (const bf16_t*)(ws + WS_CCU); g.Bt = (const bf16_t*)(ws + WS_WCO); g.N = D; g.K = MIXP; E.mode = pg8::MODE_MG2; break;
        case 7:  g.A = (const bf16_t*)(ws + WS_MG); g.Bt = (const bf16_t*)(ws + WS_WOUT); g.N = D; g.K = D; E.mode = pg8::MODE_RES; E.ssp_out_off = (unsigned)WS_SSP2; break;
        case 8:  g.A = (const bf16_t*)(ws + WS_HB); g.Bt = (const bf16_t*)(ws + WS_W2); g.N = 2 * FF; g.K = D; E.mode = pg8::MODE_GU; E.ssp_in_off = (unsigned)WS_SSP2; break;
        case 9:  g.A = (const bf16_t*)(ws + WS_A1); g.Bt = (const bf16_t*)(ws + WS_W2D); g.N = D; g.K = FF; E.mode = pg8::MODE_RES; E.scale = 0.5f; E.ssp_out_off = (unsigned)WS_SSP3; sync_after = false; break;
        case 10: g.A = (const bf16_t*)(ws + WS_PE); g.Bt = (const bf16_t*)(ws + WS_WPLE); g.N = D; g.K = DPLE; E.mode = pg8::MODE_F32; break;
        default: g.A = (const bf16_t*)(ws + WS_HB); g.Bt = (const bf16_t*)(ws + WS_WPG); g.N = D; g.K = D; E.mode = pg8::MODE_OUT; E.ssp_in_off = (unsigned)WS_SSP3; break;
        }
        E.mypm = -1; E.rtab = (const LAS float*)(lds + RING_BYTES);
        if ((E.ssp_in_off || E.xp) && G == 256) {
            const int c_ = (int)blockIdx.x, pmq = 8 * (c_ & 7) + ((c_ >> 3) & 7); int t_ = threadIdx.x; asm volatile("" : "+v"(t_));
            if (E.xp && t_ >= 256) ((LAS float*)(lds + RING_BYTES))[t_] = ((const float*)(ws + WS_RMS0))[pmq * 256 + t_ - 256];
            if (E.ssp_in_off && t_ < 256) { const float* p_ = (const float*)(ws + E.ssp_in_off) + (size_t)(pmq * 256 + t_); float s_ = 0.f;
#pragma unroll
                for (int k_ = 0; k_ < 32; k_ += 4) s_ += (p_[(size_t)k_ * M] + p_[(size_t)(k_ + 1) * M]) + (p_[(size_t)(k_ + 2) * M] + p_[(size_t)(k_ + 3) * M]);
                ((LAS float*)(lds + RING_BYTES))[t_] = rsqrtf(s_ * (1.0f / D) + EPS); }
            __syncthreads(); E.mypm = pmq;
        }
        pg8::PhaseOrder S; const int nsplit = (step == 10) ? 1 : (g.N == D ? 8 : 4); E.S = nsplit; S.init(g.N, g.K, nsplit, G, (int)blockIdx.x); S.lin = (step == 10 && G == 256);
        pg8::gemm_phase<pg8::Epi, pg8::PhaseOrder, true, true>(lds, g, S, E);
        {   const int c = (int)blockIdx.x; int tlane = threadIdx.x; asm volatile("" : "+v"(tlane)); tlane &= 63;
            if (G != 256) {} else if (step == 5 && c >= 64) convert_jobs(args, J_W2, J_W2 + 1, (c - 64) * NWAVES + wave, 192 * NWAVES, lds, wave, tlane);
            else if (step == 8 && c >= 128) convert_jobs(args, J_W2D, J_W2D + 1, (c - 128) * NWAVES + wave, 128 * NWAVES, lds, wave, tlane);
        }
        SEAM(step, sync_after);
    }
#undef SEAM
}

#ifndef N_LAUNCHES
#define N_LAUNCHES 1
#endif
extern "C" void kernel_launch(void* const* d_in, const int* in_sizes, int n_in, void* d_out, int out_size, void* d_ws, size_t ws_size, hipStream_t stream) {
    static int grid = 0;
    if (grid == 0) {
        if (n_in != 28 || (size_t)out_size != O_END || ws_size < WS_END) { fprintf(stderr, "kernel_launch: unexpected shapes: n_in %d out %d ws %zu (need %zu)\n", n_in, out_size, ws_size, (size_t)WS_END); grid = -1; return; }
        int dev = 0, cus = 0, per_cu = 0;
        hipGetDevice(&dev); hipDeviceGetAttribute(&cus, hipDeviceAttributeMultiprocessorCount, dev);
        if (hipFuncSetAttribute((const void*)fwd_kernel, hipFuncAttributeMaxDynamicSharedMemorySize, LDS_BYTES) != hipSuccess) { fprintf(stderr, "kernel_launch: hipFuncSetAttribute failed\n"); grid = -1; return; }
        if (hipOccupancyMaxActiveBlocksPerMultiprocessor(&per_cu, (const void*)fwd_kernel, NTHR, LDS_BYTES) != hipSuccess || per_cu < 1) { fprintf(stderr, "kernel_launch: occupancy query says %d\n", per_cu); per_cu = 1; }
        (void)hipGetLastError();
        grid = cus * 1;
        if (grid <= 0) grid = 256;
    }
    if (grid < 0) return;
    Args a{};
    for (int i = 0; i < 28; ++i) a.in[i] = (const float*)d_in[i];
    a.out = (float*)d_out; a.ws = (unsigned char*)d_ws;
#if N_LAUNCHES == 1
    if (hipMemsetAsync((char*)d_ws + WS_CTL, 0, CTL_ZERO_BYTES, stream) != hipSuccess) { fprintf(stderr, "kernel_launch: memset failed\n"); return; }
    a.lo = 0; a.hi = NSTEPS;
    void* kargs[] = {&a};
    hipError_t e = hipLaunchCooperativeKernel((const void*)fwd_kernel, dim3(grid), dim3(NTHR), kargs, LDS_BYTES, stream);
    if (e != hipSuccess) fprintf(stderr, "kernel_launch: cooperative launch failed: %s (grid %d)\n", hipGetErrorString(e), grid);
#else
    for (int s = 0; s < NSTEPS; ++s) { a.lo = s; a.hi = s + 1; hipLaunchKernelGGL(fwd_kernel, dim3(grid), dim3(NTHR), LDS_BYTES, stream, a); }
#endif
}
```
